# Optimizing an MI355X kernel written in HIP

```python
import jax, jax.numpy as jnp
from jax import lax
import numpy as np

D_MODEL = 1024
BATCH = 16
SEQ = 4096
DEPTH = 1

GRID_W = 64
MIX_WIDTH = D_MODEL
NA_WIDTH = MIX_WIDTH // 2
HG_WIDTH = MIX_WIDTH - NA_WIDTH
NA_HEADS = 8
NA_HEAD_DIM = NA_WIDTH // NA_HEADS
NA_ROWS = 8
NA_COLS = 16
NA_QCB = 16
NA_KCB = 2 * NA_QCB
HG_HEAD_DIM = 128
HG_HEADS = HG_WIDTH // HG_HEAD_DIM
HG_CHUNK = 64
PLE_DIM = 256
NORM_EPS = 1e-6
PROJ_WIDTHS = (NA_WIDTH, NA_WIDTH, NA_WIDTH, NA_WIDTH,
               HG_WIDTH, HG_WIDTH, HG_WIDTH, HG_WIDTH, HG_WIDTH)
PROJ_TOTAL = sum(PROJ_WIDTHS)

kernel_name = "hymba_natten_hgrn2_encoder_layer"


def rms_norm(x, g):
    xf = x.astype(jnp.float32)
    y = xf * lax.rsqrt(jnp.mean(xf * xf, axis=-1, keepdims=True) + NORM_EPS)
    return (y * g.astype(jnp.float32)).astype(x.dtype)


def group_rms_norm(x, g, n_heads):
    B, S, W = x.shape
    xh = x.reshape(B, S, n_heads, W // n_heads)
    gh = g.reshape(n_heads, W // n_heads)
    return rms_norm(xh, gh).reshape(B, S, W)


def neighborhood_attention(q, k, v, rpb):
    B, S, _ = q.shape
    rows = S // GRID_W
    kh = min(NA_ROWS, rows)

    def to_grid(t):
        return t.reshape(B, rows, GRID_W, NA_HEADS, NA_HEAD_DIM).transpose(0, 3, 1, 2, 4)

    qg, kg, vg = to_grid(q), to_grid(k), to_grid(v)

    ncb = GRID_W // NA_QCB
    cols = np.arange(GRID_W)
    col_start = np.clip(cols - NA_COLS // 2, 0, GRID_W - NA_COLS)
    band_start = np.clip(np.arange(ncb) * NA_QCB - NA_COLS // 2, 0, GRID_W - NA_KCB)
    band_idx = band_start[:, None] + np.arange(NA_KCB)[None, :]
    qcol = cols.reshape(ncb, NA_QCB)[:, :, None]
    kcol = band_idx[:, None, :]
    cs = col_start.reshape(ncb, NA_QCB)[:, :, None]
    col_mask = (kcol >= cs) & (kcol < cs + NA_COLS)
    dc_idx = np.clip(kcol - qcol + NA_COLS - 1, 0, 2 * NA_COLS - 2)
    scale = NA_HEAD_DIM ** -0.5

    def row_block(r):
        rs = jnp.clip(r - kh // 2, 0, rows - kh)
        k_rows = lax.dynamic_slice_in_dim(kg, rs, kh, axis=2)
        v_rows = lax.dynamic_slice_in_dim(vg, rs, kh, axis=2)
        k_band = k_rows[:, :, :, band_idx, :]
        v_band = v_rows[:, :, :, band_idx, :]
        q_row = lax.dynamic_index_in_dim(qg, r, axis=2, keepdims=False)
        q_row = q_row.reshape(B, NA_HEADS, ncb, NA_QCB, NA_HEAD_DIM)
        s = jnp.einsum('bhnqd,bhinjd->bhnqij', q_row, k_band).astype(jnp.float32) * scale
        dr_idx = rs + jnp.arange(kh) - r + NA_ROWS - 1
        bias = rpb[:, dr_idx][:, :, dc_idx]
        bias = bias.transpose(0, 2, 3, 1, 4).astype(jnp.float32)
        s = jnp.where(col_mask[:, :, None, :], s + bias, -jnp.inf)
        shp = s.shape
        pr = jax.nn.softmax(s.reshape(shp[:-2] + (kh * NA_KCB,)), axis=-1).reshape(shp)
        o = jnp.einsum('bhnqij,bhinjd->bhnqd', pr.astype(v.dtype), v_band)
        return o.reshape(B, NA_HEADS, GRID_W, NA_HEAD_DIM)

    out = lax.map(row_block, jnp.arange(rows))
    return out.transpose(1, 0, 3, 2, 4).reshape(B, S, NA_WIDTH)


def _hgrn2_chunk_step(state, inp):
    qc, kc, vc, gc = inp
    C = qc.shape[2]
    b = jnp.cumsum(gc, axis=2)
    tri = jnp.tril(jnp.ones((C, C), dtype=bool))[:, :, None]
    inter = jnp.einsum('nhtk,nhkv->nhtv', qc * jnp.exp(b), state)
    diff = b[:, :, :, None, :] - b[:, :, None, :, :]
    decay = jnp.where(tri, jnp.exp(jnp.where(tri, diff, 0.0)), 0.0)
    scores = jnp.einsum('nhtk,nhsk,nhtsk->nhts', qc, kc, decay)
    intra = jnp.einsum('nhts,nhsv->nhtv', scores, vc)
    b_last = b[:, :, -1, :]
    new_state = jnp.exp(b_last)[..., None] * state + jnp.einsum(
        'nhsk,nhsv->nhkv', kc * jnp.exp(b_last[:, :, None, :] - b), vc)
    return new_state, inter + intra


def hgrn2_bidirectional(q_pre, f_pre_fwd, f_pre_bwd, i_in, lb):
    B, S, _ = q_pre.shape
    f32 = jnp.float32
    q = jax.nn.silu(q_pre.astype(f32))
    v = i_in.astype(f32)
    lbf = lb.astype(f32)[:, None, None, :]
    f = lbf + (1.0 - lbf) * jax.nn.sigmoid(jnp.stack([f_pre_fwd, f_pre_bwd]).astype(f32))
    logf = jnp.log(f)
    k = 1.0 - f
    qq = jnp.concatenate([q, jnp.flip(q, 1)], 0)
    kk = jnp.concatenate([k[0], jnp.flip(k[1], 1)], 0)
    vv = jnp.concatenate([v, jnp.flip(v, 1)], 0)
    gg = jnp.concatenate([logf[0], jnp.flip(logf[1], 1)], 0)
    nc = S // HG_CHUNK

    def chunks(t):
        t = t.reshape(2 * B, S, HG_HEADS, HG_HEAD_DIM).transpose(0, 2, 1, 3)
        return jnp.moveaxis(t.reshape(2 * B, HG_HEADS, nc, HG_CHUNK, HG_HEAD_DIM), 2, 0)

    state0 = jnp.zeros((2 * B, HG_HEADS, HG_HEAD_DIM, HG_HEAD_DIM), f32)
    _, o = lax.scan(_hgrn2_chunk_step, state0, (chunks(qq), chunks(kk), chunks(vv), chunks(gg)))
    o = jnp.moveaxis(o, 0, 2).reshape(2 * B, HG_HEADS, S, HG_HEAD_DIM)
    o = o[:B] + jnp.flip(o[B:], axis=2)
    return o.transpose(0, 2, 1, 3).reshape(B, S, HG_WIDTH)


def setup_inputs(seed: int = 0) -> dict:
    key = jax.random.key(seed)
    ks = jax.random.split(key, 13)
    f32 = jnp.float32
    x = jax.random.normal(ks[0], (BATCH, SEQ, D_MODEL), f32)
    p = jax.random.normal(ks[1], (DEPTH, BATCH, SEQ, PLE_DIM), f32)
    ln_mix = 1.0 + 0.02 * jax.random.normal(ks[2], (DEPTH, D_MODEL), f32)
    w_in = jax.random.normal(ks[3], (DEPTH, D_MODEL, PROJ_TOTAL), f32) * D_MODEL ** -0.5
    rpb = 0.1 * jax.random.normal(ks[4], (DEPTH, NA_HEADS, 2 * NA_ROWS - 1, 2 * NA_COLS - 1), f32)
    lb_logits = 0.5 * jax.random.normal(ks[5], (DEPTH + 1, 2, HG_WIDTH), f32)
    attn_norm = 1.0 + 0.02 * jax.random.normal(ks[6], (DEPTH, NA_WIDTH), f32)
    hgrn_norm = 1.0 + 0.02 * jax.random.normal(ks[7], (DEPTH, HG_WIDTH), f32)
    w_out = jax.random.normal(ks[8], (DEPTH, MIX_WIDTH, D_MODEL), f32) * MIX_WIDTH ** -0.5
    ln_ple = 1.0 + 0.02 * jax.random.normal(ks[9], (DEPTH, D_MODEL), f32)
    w_pg = jax.random.normal(ks[10], (DEPTH, D_MODEL, D_MODEL), f32) * D_MODEL ** -0.5
    w_pp = jax.random.normal(ks[11], (DEPTH, PLE_DIM, D_MODEL), f32) * PLE_DIM ** -0.5
    ln_final = 1.0 + 0.02 * jax.random.normal(ks[12], (D_MODEL,), f32)
    return {"x": x, "p": p, "ln_mix": ln_mix, "w_in": w_in, "rpb": rpb,
            "lb_logits": lb_logits, "attn_norm": attn_norm, "hgrn_norm": hgrn_norm,
            "w_out": w_out, "ln_ple": ln_ple, "w_pg": w_pg, "w_pp": w_pp,
            "ln_final": ln_final}


def reference(x, p, ln_mix, w_in, rpb, lb_logits, attn_norm, hgrn_norm, w_out,
              ln_ple, w_pg, w_pp, ln_final):
    lb_all = jnp.cumsum(jax.nn.softmax(lb_logits.astype(jnp.float32), axis=0), axis=0)
    split_at = list(np.cumsum(PROJ_WIDTHS)[:-1])
    h = x
    for layer in range(DEPTH):
        hn = rms_norm(h, ln_mix[layer])
        proj = hn @ w_in[layer]
        aq, ak, av, ag, hq, hf_f, hf_b, hi, hg = jnp.split(proj, split_at, axis=-1)
        a = neighborhood_attention(aq, ak, av, rpb[layer])
        a = group_rms_norm(a, attn_norm[layer], NA_HEADS) * jax.nn.silu(ag)
        r = hgrn2_bidirectional(hq, hf_f, hf_b, hi, lb_all[layer]).astype(h.dtype)
        r = group_rms_norm(r, hgrn_norm[layer], HG_HEADS) * jax.nn.silu(hg)
        h = h + jnp.concatenate([a, r], axis=-1) @ w_out[layer]
        gate = jax.nn.sigmoid(rms_norm(h, ln_ple[layer]) @ w_pg[layer])
        h = h + gate * (p[layer] @ w_pp[layer])
    return rms_norm(h, ln_final)
```

```cpp
#include <hip/hip_runtime.h>
#include <hip/hip_cooperative_groups.h>
#include <cstdio>
namespace cg = cooperative_groups;

#ifndef N_LAUNCHES
#define N_LAUNCHES 1
#define PROBE_DUP -1
#endif

#define LAS __attribute__((address_space(3)))
typedef unsigned short bf16_t;
typedef short bf16x8 __attribute__((ext_vector_type(8)));
typedef float f32x2 __attribute__((ext_vector_type(2)));
typedef float f32x4 __attribute__((ext_vector_type(4)));
typedef float f32x16 __attribute__((ext_vector_type(16)));
typedef unsigned u32x2 __attribute__((ext_vector_type(2)));
typedef unsigned u32x4 __attribute__((ext_vector_type(4)));

constexpr int NTOK = 65536, DM = 1024, SEQ = 4096;
constexpr float EPS = 1e-6f;
constexpr size_t MiB = 1ull << 20;
constexpr size_t OFF_XB = 0, OFF_MIX = 0;
constexpr size_t OFF_Q = 128 * MiB, OFF_K = 192 * MiB, OFF_VT = 256 * MiB, OFF_SG = 320 * MiB, OFF_HQ = 384 * MiB;
constexpr size_t OFF_GF = 448 * MiB  , OFF_HIT = 576 * MiB, OFF_SHG = 640 * MiB;
constexpr size_t OFF_OD = 704 * MiB, OFF_HB = OFF_VT  , OFF_PB = 832 * MiB, OFF_PP = OFF_Q;
constexpr size_t OFF_HFB = OFF_GF  ;
constexpr size_t OFF_W1T = 864 * MiB, OFF_W2T = 873 * MiB, OFF_W3T = 875 * MiB, OFF_W4T = 877 * MiB;
constexpr size_t OFF_RSTD1 = 878 * MiB, OFF_SS2 = OFF_RSTD1 + 256 * 1024, OFF_SS3 = OFF_SS2 + 256 * 1024, OFF_LB = OFF_SS3 + 256 * 1024;
constexpr size_t OFF_BAR = 879 * MiB;
constexpr size_t WS_END = 880 * MiB;
constexpr int LDS_BYTES = 131072 + 2048 + 64;

struct Params {
    const float *x, *p, *ln_mix, *w_in, *rpb, *lb_logits, *attn_norm, *hgrn_norm, *w_out, *ln_ple, *w_pg, *w_pp, *ln_final;
    float* out;
    unsigned char* ws;
};

typedef __bf16 bf16x2v __attribute__((ext_vector_type(2)));
__device__ __forceinline__ unsigned pk2(float lo, float hi) { f32x2 v = {lo, hi}; bf16x2v b = __builtin_convertvector(v, bf16x2v); return __builtin_bit_cast(unsigned, b); }
__device__ __forceinline__ float bf_lo(unsigned u) { return __uint_as_float(u << 16); }
__device__ __forceinline__ float bf_hi(unsigned u) { return __uint_as_float(u & 0xffff0000u); }
__device__ __forceinline__ float bf1(bf16_t u) { return __uint_as_float(((unsigned)u) << 16); }
__device__ __forceinline__ float sigmoidf_(float v) { return __builtin_amdgcn_rcpf(1.0f + __expf(-v)); }
__device__ __forceinline__ float siluf_(float v) { return v * __builtin_amdgcn_rcpf(1.0f + __expf(-v)); }
__device__ __forceinline__ float wave_sum(float v) {
#pragma unroll
    for (int o = 1; o < 64; o <<= 1) v += __shfl_xor(v, o);
    return v;
}
#define LDS_BAR() do { asm volatile("s_waitcnt lgkmcnt(0)" ::: "memory"); __builtin_amdgcn_s_barrier(); asm volatile("" ::: "memory"); } while (0)

#define XB_TMO      128
#define XB_XCNT(j)  (256  + 64 * (j))
#define XB_XSUB(j)  (1280 + 64 * (j))
#define XB_XGEN(j)  (2304 + 64 * (j))
#define XB_TOP      3328
#define XB_TOPGEN   3392
#define XCD_BAR_WORDS 3456
#define XB_SPIN_CAP (1u << 20)
__device__ __forceinline__ unsigned xb_ld(unsigned* p)              { return __hip_atomic_load(p, __ATOMIC_RELAXED, __HIP_MEMORY_SCOPE_AGENT); }
__device__ __forceinline__ unsigned xb_add(unsigned* p, unsigned v) { return __hip_atomic_fetch_add(p, v, __ATOMIC_RELAXED, __HIP_MEMORY_SCOPE_AGENT); }
__device__ __forceinline__ unsigned xb_xcc_id() { return (unsigned)__builtin_amdgcn_s_getreg((3 << 11) | 20) & 0xFu; }
#define XB_SPIN(cond, bar) do { unsigned _sp = 0; while (cond) { __builtin_amdgcn_s_sleep(1); \
    if ((++_sp & 255u) == 0u) { if (xb_ld(&(bar)[XB_TMO])) break; if (_sp > XB_SPIN_CAP) { atomicAdd(&(bar)[XB_TMO], 1u); break; } } } } while (0)
struct XcdBarrier { unsigned* bar; unsigned x; volatile LAS unsigned* st; };
__device__ __forceinline__ XcdBarrier xcd_barrier_post(unsigned* bar, volatile LAS unsigned* st) {
    XcdBarrier b; b.bar = bar; b.x = xb_xcc_id(); b.st = st;
    if (threadIdx.x == 0) (void)xb_add(&bar[XB_XCNT(b.x)], 1u);
    return b;
}
__device__ __forceinline__ void xcd_barrier_complete(unsigned* bar, unsigned x, unsigned& nloc, unsigned& nx) {
    const unsigned G = gridDim.x * gridDim.y * gridDim.z;
    unsigned sum, cnt, mine, sp = 0u;
    for (;;) {
        sum = 0u; cnt = 0u; mine = 0u;
#pragma unroll
        for (unsigned j = 0; j < 16; ++j) { const unsigned c = xb_ld(&bar[XB_XCNT(j)]); sum += c; cnt += (c > 0u) ? 1u : 0u; mine = (j == x) ? c : mine; }
        if (sum == G) break;
        __builtin_amdgcn_s_sleep(1);
        if ((++sp & 255u) == 0u) { if (xb_ld(&bar[XB_TMO])) break; if (sp > XB_SPIN_CAP) { atomicAdd(&bar[XB_TMO], 1u); break; } }
    }
    nloc = mine > 0u ? mine : 1u; nx = cnt > 0u ? cnt : 1u;
}
__device__ __forceinline__ void xcd_barrier(const XcdBarrier& b) {
    asm volatile("s_waitcnt vmcnt(0)" ::: "memory");
    __syncthreads();
    if (threadIdx.x == 0) {
        unsigned* bar = b.bar;
        __builtin_amdgcn_s_waitcnt(0);
        unsigned nloc = b.st[0], nx = b.st[1];
        if (nloc == 0u) { xcd_barrier_complete(bar, b.x, nloc, nx); b.st[0] = nloc; b.st[1] = nx; }
        const unsigned old = xb_add(&bar[XB_XSUB(b.x)], 1u);
        const unsigned gen = old / nloc;
        if (old + 1u == (gen + 1u) * nloc) {
            __builtin_amdgcn_fence(__ATOMIC_RELEASE, "agent");
            asm volatile("s_waitcnt vmcnt(0)" ::: "memory");
            const unsigned og = xb_add(&bar[XB_TOP], 1u);
            const unsigned tg = og / nx;
            if (og + 1u == (tg + 1u) * nx) xb_add(&bar[XB_TOPGEN], 1u);
            else XB_SPIN(xb_ld(&bar[XB_TOPGEN]) == tg, bar);
            __builtin_amdgcn_fence(__ATOMIC_ACQUIRE, "agent");
            xb_add(&bar[XB_XGEN(b.x)], 1u);
            asm volatile("s_waitcnt vmcnt(0)" ::: "memory");
        } else {
            XB_SPIN(xb_ld(&bar[XB_XGEN(b.x)]) == gen, bar);
            __builtin_amdgcn_fence(__ATOMIC_ACQUIRE, "agent");
            asm volatile("s_waitcnt vmcnt(0)" ::: "memory");
        }
    }
    __syncthreads();
}

namespace pg8 {
constexpr int BM = 256, BK = 64, HALF = 128, HTB = HALF * BK * 2, STAGE_BYTES = 8 * HTB, NXCD = 8, WGM = 8;
__device__ __forceinline__ int lds_byte(int r, int c) { const int st = (r >> 4) * 2 + (c >> 5), rr = r & 15, cc = c & 31, ob = rr * 64 + cc * 2; return st * 1024 + (ob ^ (((ob >> 9) & 1) << 5)); }
__device__ __forceinline__ void stage_rc(int b, int& R, int& C) { const int st = b / 1024, sb = b % 1024, swz = sb ^ (((sb >> 9) & 1) << 5); R = (st >> 1) * 16 + swz / 64; C = (st & 1) * 32 + (swz % 64) / 2; }
__device__ __forceinline__ int perm32(int rho) { const int n = rho >> 4, i = rho & 15; return 8 * (i >> 2) + 4 * n + (i & 3); }
struct Unit { int pm, pn; };
struct Gemm { const bf16_t* A; const bf16_t* Bt; int M, N, K; };
struct StaticOrder {
    int nM, nN, nwg, G, c;
    __device__ void init(int M, int N, int G_, int c_) { nM = M / BM; nN = N / BM; nwg = nM * nN; G = G_; c = c_; }
    __device__ bool next(int i, Unit& u) const {
        const long L = (long)i * G + c; if (L >= nwg) return false;
        int wgid = (int)L; { const int q = nwg / NXCD, r = nwg % NXCD, xcd = wgid % NXCD, off = wgid / NXCD; wgid = (xcd < r ? xcd * (q + 1) : r * (q + 1) + (xcd - r) * q) + off; }
        const int nig = WGM * nN, gid = wgid / nig, fm = gid * WGM, gsz = (nM - fm) < WGM ? (nM - fm) : WGM;
        u.pm = fm + ((wgid % nig) % gsz); u.pn = (wgid % nig) / gsz; return true;
    }
};
template <class Epi, class Sched>
__device__ __forceinline__ void gemm_phase(LAS unsigned char* lds, const Gemm g, const Sched& S, const Epi& E) {
    int tid_ = threadIdx.x; asm volatile("" : "+v"(tid_));
    const int tid = tid_, wid = __builtin_amdgcn_readfirstlane(tid >> 6), lane = tid & 63, wr = wid >> 2, wc = wid & 3, fr = lane & 15, fq = lane >> 4;
    const int K = g.K, nt = K / BK;
    unsigned voffA[2], voffB[2];
#pragma unroll
    for (int i = 0; i < 2; ++i) { int R, C; stage_rc(tid * 16 + i * 8192, R, C); const int Rb = (R & ~31) + perm32(R & 31);
        voffA[i] = (unsigned)(R * K + C) * 2u; voffB[i] = (unsigned)(Rb * K + C) * 2u; }
    const size_t kstep = (size_t)(BK * 2);
    const size_t hstep = (size_t)HALF * K * 2;
    const size_t tstep = 2 * hstep;
    const unsigned ldsw = (unsigned)wid * 1024u;
    const int aoff = lds_byte(wr * 64 + fr, fq * 8), boff = lds_byte(wc * 32 + fr, fq * 8);
#define PG8_SA(b, h) (((b) * 2 + (h)) * HTB)
#define PG8_SB(b, h) ((4 + (b) * 2 + (h)) * HTB)
#define PG8_STAGE(bufoff, gbase, voff) do { _Pragma("unroll") for (int _i = 0; _i < 2; ++_i) \
        __builtin_amdgcn_global_load_lds((const unsigned*)((const char*)(gbase) + (voff)[_i]), (LAS unsigned*)(lds + (bufoff) + ldsw + _i * 8192), 16, 0, 0); } while (0)
#define PG8_LDA(dst, b, h) do { _Pragma("unroll") for (int m = 0; m < 4; ++m) _Pragma("unroll") for (int k = 0; k < 2; ++k) dst[m][k] = *(const LAS bf16x8*)(lds + PG8_SA(b, h) + aoff + m * 2048 + k * 1024); } while (0)
#define PG8_LDB(dst, b, h) do { _Pragma("unroll") for (int n = 0; n < 2; ++n) _Pragma("unroll") for (int k = 0; k < 2; ++k) dst[n][k] = *(const LAS bf16x8*)(lds + PG8_SB(b, h) + boff + n * 2048 + k * 1024); } while (0)
#define PG8_MMA(ai, bj, At, Bt) do { __builtin_amdgcn_s_setprio(1); _Pragma("unroll") for (int m = 0; m < 4; ++m) _Pragma("unroll") for (int n = 0; n < 2; ++n) _Pragma("unroll") for (int k = 0; k < 2; ++k) \
        acc[ai][bj][m][n] = __builtin_amdgcn_mfma_f32_16x16x32_bf16(Bt[n][k], At[m][k], acc[ai][bj][m][n], 0, 0, 0); __builtin_amdgcn_s_setprio(0); } while (0)
#define PG8_WAIT_V(n) asm volatile("s_waitcnt vmcnt(" #n ")" ::: "memory")
#define PG8_WAIT_L(n) asm volatile("s_waitcnt lgkmcnt(" #n ")" ::: "memory")
#define PG8_BAR __builtin_amdgcn_s_barrier()
#define PG8_SCHED __builtin_amdgcn_sched_barrier(0)
    Unit cur, nxt; int ui = 0;
    if (!S.next(0, cur)) return;
    f32x4 acc[2][2][4][2];
#pragma unroll
    for (int a = 0; a < 2; ++a)
#pragma unroll
        for (int b = 0; b < 2; ++b)
#pragma unroll
            for (int m = 0; m < 4; ++m)
#pragma unroll
                for (int n = 0; n < 2; ++n) acc[a][b][m][n] = (f32x4){0.f, 0.f, 0.f, 0.f};
    bf16x8 At[4][2], B0[2][2], B1[2][2];
    const char* cA = Epi::swapped(cur) ? (const char*)g.Bt + (size_t)cur.pn * tstep : (const char*)g.A + (size_t)cur.pm * tstep;
    const char* cB = Epi::swapped(cur) ? (const char*)g.A + (size_t)cur.pm * tstep : (const char*)g.Bt + (size_t)cur.pn * tstep;
    PG8_STAGE(PG8_SB(0, 0), cB, voffB); PG8_STAGE(PG8_SA(0, 0), cA, voffA); PG8_STAGE(PG8_SB(0, 1), cB + hstep, voffB); PG8_STAGE(PG8_SA(0, 1), cA + hstep, voffA);
    if (wr == 1) PG8_BAR;
    PG8_WAIT_V(4); PG8_BAR;
    PG8_STAGE(PG8_SB(1, 0), cB + kstep, voffB); PG8_STAGE(PG8_SA(1, 0), cA + kstep, voffA); PG8_STAGE(PG8_SB(1, 1), cB + hstep + kstep, voffB);
    PG8_WAIT_V(6); PG8_BAR;
    for (;;) {
        const bool has_next = S.next(ui + 1, nxt);
        const bool nsw = has_next && Epi::swapped(nxt);
        const char* nA = has_next ? (nsw ? (const char*)g.Bt + (size_t)nxt.pn * tstep : (const char*)g.A + (size_t)nxt.pm * tstep) : cA;
        const char* nB = has_next ? (nsw ? (const char*)g.A + (size_t)nxt.pm * tstep : (const char*)g.Bt + (size_t)nxt.pn * tstep) : cB;
        for (int t = 0; t < nt; t += 2) {
            const bool last = (t == nt - 2);
            const char* a1 = cA + (size_t)(t + 1) * kstep;
            const char* a2 = last ? nA : cA + (size_t)(t + 2) * kstep; const char* b2 = last ? nB : cB + (size_t)(t + 2) * kstep;
            const char* a3 = a2 + kstep; const char* b3 = b2 + kstep;
            PG8_LDB(B0, 0, 0); PG8_SCHED; PG8_LDA(At, 0, 0); PG8_STAGE(PG8_SA(1, 1), a1 + hstep, voffA);
            PG8_WAIT_L(8); PG8_BAR; PG8_WAIT_L(0); PG8_MMA(0, 0, At, B0); PG8_BAR; PG8_SCHED;
            PG8_LDB(B1, 0, 1); PG8_STAGE(PG8_SB(0, 0), b2, voffB);
            PG8_BAR; PG8_WAIT_L(0); PG8_MMA(0, 1, At, B1); PG8_BAR;
            PG8_LDA(At, 0, 1); PG8_STAGE(PG8_SA(0, 0), a2, voffA);
            PG8_BAR; PG8_WAIT_L(0); PG8_MMA(1, 0, At, B0); PG8_BAR; PG8_SCHED;
            PG8_STAGE(PG8_SB(0, 1), b2 + hstep, voffB);
            PG8_WAIT_V(6); PG8_BAR; PG8_MMA(1, 1, At, B1); PG8_BAR;
            PG8_LDB(B0, 1, 0); PG8_SCHED; PG8_LDA(At, 1, 0); PG8_STAGE(PG8_SA(0, 1), a2 + hstep, voffA);
            PG8_WAIT_L(8); PG8_BAR; PG8_WAIT_L(0); PG8_MMA(0, 0, At, B0); PG8_BAR; PG8_SCHED;
            PG8_LDB(B1, 1, 1); PG8_STAGE(PG8_SB(1, 0), b3, voffB);
            PG8_BAR; PG8_WAIT_L(0); PG8_MMA(0, 1, At, B1); PG8_BAR;
            PG8_LDA(At, 1, 1); PG8_STAGE(PG8_SA(1, 0), a3, voffA);
            PG8_BAR; PG8_WAIT_L(0); PG8_MMA(1, 0, At, B0); PG8_BAR; PG8_SCHED;
            PG8_STAGE(PG8_SB(1, 1), b3 + hstep, voffB);
            PG8_WAIT_V(6); PG8_BAR; PG8_MMA(1, 1, At, B1); PG8_BAR;
        }
        E(acc, cur, wr, wc, fr, fq);
        if (!has_next) break;
#pragma unroll
        for (int a = 0; a < 2; ++a)
#pragma unroll
            for (int b = 0; b < 2; ++b)
#pragma unroll
                for (int m = 0; m < 4; ++m)
#pragma unroll
                    for (int n = 0; n < 2; ++n) acc[a][b][m][n] = (f32x4){0.f, 0.f, 0.f, 0.f};
        cur = nxt; cA = nA; cB = nB; ++ui;
    }
    PG8_WAIT_V(0);
    if (wr == 0) PG8_BAR;
    PG8_BAR;
#undef PG8_SA
#undef PG8_SB
#undef PG8_STAGE
#undef PG8_LDA
#undef PG8_LDB
#undef PG8_MMA
#undef PG8_WAIT_V
#undef PG8_WAIT_L
#undef PG8_BAR
#undef PG8_SCHED
}
struct PanelOrder {
    int panel, nN;
    __device__ bool next(int i, Unit& u) const { if (i >= nN) return false; u.pm = panel; u.pn = i; return true; }
};
}
using pg8::Unit;
typedef f32x4 AccT[2][2][4][2];

struct Epi1 {
    unsigned char* ws;
    static __device__ __forceinline__ bool swapped(const Unit& u) { const int grp = u.pn >> 1; return grp == 2 || grp == 7; }
    template <int GRP> __device__ __forceinline__ void run(const AccT& acc, const Unit& u, int wr, int wc, int fr, int fq) const {
        if constexpr (GRP == 2 || GRP == 7) {
            const int t00 = u.pm * 256 + wc * 32 + 8 * fq;
            const int b = t00 >> 12;
#pragma unroll
            for (int ai = 0; ai < 2; ++ai)
#pragma unroll
                for (int m = 0; m < 4; ++m) {
                    const int col = (u.pn & 1) * 256 + ai * 128 + wr * 64 + m * 16 + fr;
#pragma unroll
                    for (int bj = 0; bj < 2; ++bj) {
                        const int s = (t00 + bj * 128) & 4095;
                        float v[8];
#pragma unroll
                        for (int e = 0; e < 4; ++e) { v[e] = acc[ai][bj][m][0][e]; v[4 + e] = acc[ai][bj][m][1][e]; }
                        u32x4 w; w.x = pk2(v[0], v[1]); w.y = pk2(v[2], v[3]); w.z = pk2(v[4], v[5]); w.w = pk2(v[6], v[7]);
                        if constexpr (GRP == 2)
                            *(u32x4*)((bf16_t*)(ws + OFF_VT) + ((size_t)((b * 8 + (col >> 6)) * 64 + (s >> 6)) * 64 + (col & 63)) * 64 + (s & 63)) = w;
                        else
                            *(u32x4*)((bf16_t*)(ws + OFF_HIT) + ((size_t)(b * 512 + col)) * 4096 + s) = w;
                    }
                }
            return;
        }
        const int colg0 = (u.pn & 1) * 256 + wc * 32 + 8 * fq;
        const int row0 = u.pm * 256 + wr * 64 + fr;
        float lbv[16];
        if constexpr (GRP == 5 || GRP == 6) {
            const float* lb = (const float*)(ws + OFF_LB) + (GRP - 5) * 512 + colg0;
#pragma unroll
            for (int bj = 0; bj < 2; ++bj) {
                const f32x4 a = *(const f32x4*)(lb + bj * 128), b = *(const f32x4*)(lb + bj * 128 + 4);
#pragma unroll
                for (int e = 0; e < 4; ++e) { lbv[bj * 8 + e] = a[e]; lbv[bj * 8 + 4 + e] = b[e]; }
            }
        }
#pragma unroll
        for (int ai = 0; ai < 2; ++ai)
#pragma unroll
            for (int m = 0; m < 4; ++m) {
                const int row = row0 + ai * 128 + m * 16;
                const int b = row >> 12, s = row & 4095;
#pragma unroll
                for (int bj = 0; bj < 2; ++bj) {
                    const int col = colg0 + bj * 128;
                    float v[8];
#pragma unroll
                    for (int e = 0; e < 4; ++e) { v[e] = acc[ai][bj][m][0][e]; v[4 + e] = acc[ai][bj][m][1][e]; }
                    if constexpr (GRP == 7) {
                        bf16_t* base = (bf16_t*)(ws + OFF_HIT) + ((size_t)(b * 512 + col)) * 4096 + s;
#pragma unroll
                        for (int e = 0; e < 8; ++e) base[(size_t)e * 4096] = (bf16_t)(pk2(v[e], 0.f) & 0xffffu);
                    } else if constexpr (GRP == 2) {
                        bf16_t* base = (bf16_t*)(ws + OFF_VT) + ((size_t)((b * 8 + (col >> 6)) * 64 + (s >> 6)) * 64 + (col & 63)) * 64 + (s & 63);
#pragma unroll
                        for (int e = 0; e < 8; ++e) base[e * 64] = (bf16_t)(pk2(v[e], 0.f) & 0xffffu);
                    } else if constexpr (GRP <= 1) {
                        if constexpr (GRP == 0) {
#pragma unroll
                            for (int e = 0; e < 8; ++e) v[e] *= 0.18033688011112042f;
                        }
                        u32x4 w; w.x = pk2(v[0], v[1]); w.y = pk2(v[2], v[3]); w.z = pk2(v[4], v[5]); w.w = pk2(v[6], v[7]);
                        *(u32x4*)((bf16_t*)(ws + (GRP == 0 ? OFF_Q : OFF_K)) + ((size_t)(b * 8 + (col >> 6)) * 4096 + s) * 64 + (col & 63)) = w;
                    } else {
                        if constexpr (GRP == 3 || GRP == 8) {
                        } else if constexpr (GRP == 4) {
#pragma unroll
                            for (int e = 0; e < 8; ++e) v[e] = siluf_(v[e]);
                        } else {
#pragma unroll
                            for (int e = 0; e < 8; ++e) { const float l = lbv[bj * 8 + e]; v[e] = __builtin_amdgcn_logf(l + (1.0f - l) * sigmoidf_(v[e]));   }
                        }
                        constexpr size_t off = GRP == 3 ? OFF_SG : GRP == 4 ? OFF_HQ : GRP == 5 ? OFF_GF : GRP == 6 ? OFF_GF + 64 * MiB : OFF_SHG;
                        u32x4 w; w.x = pk2(v[0], v[1]); w.y = pk2(v[2], v[3]); w.z = pk2(v[4], v[5]); w.w = pk2(v[6], v[7]);
                        *(u32x4*)((bf16_t*)(ws + off) + (size_t)row * 512 + col) = w;
                    }
                }
            }
    }
    __device__ __forceinline__ void operator()(const AccT& acc, const Unit& u, int wr, int wc, int fr, int fq) const {
        asm volatile("" : "+v"(fr), "+v"(fq));
        switch (u.pn >> 1) {
            case 0: run<0>(acc, u, wr, wc, fr, fq); break; case 1: run<1>(acc, u, wr, wc, fr, fq); break; case 2: run<2>(acc, u, wr, wc, fr, fq); break;
            case 3: run<3>(acc, u, wr, wc, fr, fq); break; case 4: run<4>(acc, u, wr, wc, fr, fq); break; case 5: run<5>(acc, u, wr, wc, fr, fq); break;
            case 6: run<6>(acc, u, wr, wc, fr, fq); break; case 7: run<7>(acc, u, wr, wc, fr, fq); break; default: run<8>(acc, u, wr, wc, fr, fq); break;
        }
    }
};
struct EpiPP {
    static __device__ __forceinline__ bool swapped(const Unit&) { return false; }
    bf16_t* O;
    __device__ __forceinline__ void operator()(const AccT& acc, const Unit& u, int wr, int wc, int fr, int fq) const {
        asm volatile("" : "+v"(fr), "+v"(fq));
        const int row0 = u.pm * 256 + wr * 64 + fr, col0 = u.pn * 256 + wc * 32 + 8 * fq;
#pragma unroll
        for (int ai = 0; ai < 2; ++ai)
#pragma unroll
            for (int m = 0; m < 4; ++m)
#pragma unroll
                for (int bj = 0; bj < 2; ++bj) {
                    const f32x4 v0 = acc[ai][bj][m][0], v1 = acc[ai][bj][m][1];
                    u32x4 w; w.x = pk2(v0[0], v0[1]); w.y = pk2(v0[2], v0[3]); w.z = pk2(v1[0], v1[1]); w.w = pk2(v1[2], v1[3]);
                    *(u32x4*)(O + (size_t)(row0 + ai * 128 + m * 16) * 1024 + col0 + bj * 128) = w;
                }
    }
};
struct Epi2 {
    static __device__ __forceinline__ bool swapped(const Unit&) { return false; }
    const float* x; float* out; bf16_t* hb; float* ss;
    __device__ __forceinline__ void operator()(const AccT& acc, const Unit& u, int wr, int wc, int fr, int fq) const {
        asm volatile("" : "+v"(fr), "+v"(fq));
        const int row0 = u.pm * 256 + wr * 64 + fr, col0 = u.pn * 256 + wc * 32 + 8 * fq;
#pragma unroll
        for (int ai = 0; ai < 2; ++ai) {
            f32x4 xv[4][2][2];
#pragma unroll
            for (int m = 0; m < 4; ++m)
#pragma unroll
                for (int bj = 0; bj < 2; ++bj) {
                    const size_t o = (size_t)(row0 + ai * 128 + m * 16) * 1024 + col0 + bj * 128;
                    xv[m][bj][0] = *(const f32x4*)(x + o); xv[m][bj][1] = *(const f32x4*)(x + o + 4);
                }
#pragma unroll
            for (int m = 0; m < 4; ++m) {
                const int row = row0 + ai * 128 + m * 16;
                float s2 = 0.f;
#pragma unroll
                for (int bj = 0; bj < 2; ++bj) {
                    const size_t o = (size_t)row * 1024 + col0 + bj * 128;
                    const f32x4 h0 = xv[m][bj][0] + acc[ai][bj][m][0], h1 = xv[m][bj][1] + acc[ai][bj][m][1];
                    *(f32x4*)(out + o) = h0; *(f32x4*)(out + o + 4) = h1;
                    u32x4 w; w.x = pk2(h0[0], h0[1]); w.y = pk2(h0[2], h0[3]); w.z = pk2(h1[0], h1[1]); w.w = pk2(h1[2], h1[3]);
                    *(u32x4*)(hb + o) = w;
                    s2 += h0[0] * h0[0] + h0[1] * h0[1] + h0[2] * h0[2] + h0[3] * h0[3] + h1[0] * h1[0] + h1[1] * h1[1] + h1[2] * h1[2] + h1[3] * h1[3];
                }
                s2 += __shfl_xor(s2, 16); s2 += __shfl_xor(s2, 32);
                if (fq == 0) atomicAdd(ss + row, s2);
            }
        }
    }
};
struct Epi3 {
    static __device__ __forceinline__ bool swapped(const Unit&) { return false; }
    float* out; const bf16_t* pp; const float* ss2; float* ss3;
    __device__ __forceinline__ void operator()(const AccT& acc, const Unit& u, int wr, int wc, int fr, int fq) const {
        asm volatile("" : "+v"(fr), "+v"(fq));
        const int row0 = u.pm * 256 + wr * 64 + fr, col0 = u.pn * 256 + wc * 32 + 8 * fq;
        float rsv[8];
#pragma unroll
        for (int i = 0; i < 8; ++i) rsv[i] = ss2[row0 + (i >> 2) * 128 + (i & 3) * 16];
#pragma unroll
        for (int ai = 0; ai < 2; ++ai)
#pragma unroll
            for (int mh = 0; mh < 2; ++mh) {
                f32x4 hv[2][2][2]; u32x4 pw[2][2];
#pragma unroll
                for (int mm = 0; mm < 2; ++mm)
#pragma unroll
                    for (int bj = 0; bj < 2; ++bj) {
                        const size_t o = (size_t)(row0 + ai * 128 + (mh * 2 + mm) * 16) * 1024 + col0 + bj * 128;
                        hv[mm][bj][0] = *(const f32x4*)(out + o); hv[mm][bj][1] = *(const f32x4*)(out + o + 4); pw[mm][bj] = *(const u32x4*)(pp + o);
                    }
#pragma unroll
                for (int mm = 0; mm < 2; ++mm) {
                    const int m = mh * 2 + mm, row = row0 + ai * 128 + m * 16;
                    const float rs = rsqrtf(rsv[ai * 4 + m] * (1.0f / 1024.0f) + EPS);
                    float s2 = 0.f;
#pragma unroll
                    for (int bj = 0; bj < 2; ++bj) {
                        const size_t o = (size_t)row * 1024 + col0 + bj * 128;
                        const u32x4 q = pw[mm][bj];
                        const float pv[8] = {bf_lo(q.x), bf_hi(q.x), bf_lo(q.y), bf_hi(q.y), bf_lo(q.z), bf_hi(q.z), bf_lo(q.w), bf_hi(q.w)};
                        f32x4 r0, r1;
#pragma unroll
                        for (int e = 0; e < 4; ++e) {
                            r0[e] = hv[mm][bj][0][e] + sigmoidf_(acc[ai][bj][m][0][e] * rs) * pv[e];
                            r1[e] = hv[mm][bj][1][e] + sigmoidf_(acc[ai][bj][m][1][e] * rs) * pv[4 + e];
                            s2 += r0[e] * r0[e] + r1[e] * r1[e];
                        }
                        *(f32x4*)(out + o) = r0; *(f32x4*)(out + o + 4) = r1;
                    }
                    s2 += __shfl_xor(s2, 16); s2 += __shfl_xor(s2, 32);
                    if (fq == 0) atomicAdd(ss3 + row, s2);
                }
            }
    }
};

struct Epi2P {
    static __device__ __forceinline__ bool swapped(const Unit&) { return false; }
    const float* x; float* out; bf16_t* hb; LAS float* ssl;
    __device__ __forceinline__ void operator()(const AccT& acc, const Unit& u, int wr, int wc, int fr, int fq) const {
        asm volatile("" : "+v"(fr), "+v"(fq));
        const int lrow0 = wr * 64 + fr, row0 = u.pm * 256 + lrow0, col0 = u.pn * 256 + wc * 32 + 8 * fq;
#pragma unroll
        for (int ai = 0; ai < 2; ++ai) {
            f32x4 xv[4][2][2];
#pragma unroll
            for (int m = 0; m < 4; ++m)
#pragma unroll
                for (int bj = 0; bj < 2; ++bj) {
                    const size_t o = (size_t)(row0 + ai * 128 + m * 16) * 1024 + col0 + bj * 128;
                    xv[m][bj][0] = *(const f32x4*)(x + o); xv[m][bj][1] = *(const f32x4*)(x + o + 4);
                }
#pragma unroll
            for (int m = 0; m < 4; ++m) {
                const int row = row0 + ai * 128 + m * 16;
                float s2 = 0.f;
#pragma unroll
                for (int bj = 0; bj < 2; ++bj) {
                    const size_t o = (size_t)row * 1024 + col0 + bj * 128;
                    const f32x4 h0 = xv[m][bj][0] + acc[ai][bj][m][0], h1 = xv[m][bj][1] + acc[ai][bj][m][1];
                    u32x4 w; w.x = pk2(h0[0], h0[1]); w.y = pk2(h0[2], h0[3]); w.z = pk2(h1[0], h1[1]); w.w = pk2(h1[2], h1[3]);
                    *(u32x4*)(hb + o) = w;
                    s2 += h0[0] * h0[0] + h0[1] * h0[1] + h0[2] * h0[2] + h0[3] * h0[3] + h1[0] * h1[0] + h1[1] * h1[1] + h1[2] * h1[2] + h1[3] * h1[3];
                }
                s2 += __shfl_xor(s2, 16); s2 += __shfl_xor(s2, 32);
                if (fq == 0) __hip_atomic_fetch_add(ssl + lrow0 + ai * 128 + m * 16, s2, __ATOMIC_RELAXED, __HIP_MEMORY_SCOPE_WORKGROUP);
            }
        }
    }
};
struct Epi3P {
    static __device__ __forceinline__ bool swapped(const Unit&) { return false; }
    bf16_t* hfb; const bf16_t* pp; const bf16_t* hb; const LAS float* ss2l; LAS float* ss3l;
    __device__ __forceinline__ void operator()(const AccT& acc, const Unit& u, int wr, int wc, int fr, int fq) const {
        asm volatile("" : "+v"(fr), "+v"(fq));
        const int lrow0 = wr * 64 + fr, row0 = u.pm * 256 + lrow0, col0 = u.pn * 256 + wc * 32 + 8 * fq;
#pragma unroll
        for (int ai = 0; ai < 2; ++ai) {
            u32x4 hw[4][2], pw[4][2];
#pragma unroll
            for (int m = 0; m < 4; ++m)
#pragma unroll
                for (int bj = 0; bj < 2; ++bj) {
                    const size_t o = (size_t)(row0 + ai * 128 + m * 16) * 1024 + col0 + bj * 128;
                    hw[m][bj] = *(const u32x4*)(hb + o); pw[m][bj] = *(const u32x4*)(pp + o);
                }
#pragma unroll
            for (int m = 0; m < 4; ++m) {
                const int lrow = lrow0 + ai * 128 + m * 16, row = u.pm * 256 + lrow;
                const float rs = rsqrtf(ss2l[lrow] * (1.0f / 1024.0f) + EPS);
                float s2 = 0.f;
#pragma unroll
                for (int bj = 0; bj < 2; ++bj) {
                    const size_t o = (size_t)row * 1024 + col0 + bj * 128;
                    const u32x4 q = pw[m][bj], hq = hw[m][bj];
                    const float pv[8] = {bf_lo(q.x), bf_hi(q.x), bf_lo(q.y), bf_hi(q.y), bf_lo(q.z), bf_hi(q.z), bf_lo(q.w), bf_hi(q.w)};
                    const float hv[8] = {bf_lo(hq.x), bf_hi(hq.x), bf_lo(hq.y), bf_hi(hq.y), bf_lo(hq.z), bf_hi(hq.z), bf_lo(hq.w), bf_hi(hq.w)};
                    f32x4 r0, r1;
#pragma unroll
                    for (int e = 0; e < 4; ++e) {
                        r0[e] = hv[e] + sigmoidf_(acc[ai][bj][m][0][e] * rs) * pv[e];
                        r1[e] = hv[4 + e] + sigmoidf_(acc[ai][bj][m][1][e] * rs) * pv[4 + e];
                        s2 += r0[e] * r0[e] + r1[e] * r1[e];
                    }
                    u32x4 w; w.x = pk2(r0[0], r0[1]); w.y = pk2(r0[2], r0[3]); w.z = pk2(r1[0], r1[1]); w.w = pk2(r1[2], r1[3]);
                    *(u32x4*)(hfb + o) = w;
                }
                s2 += __shfl_xor(s2, 16); s2 += __shfl_xor(s2, 32);
                if (fq == 0) __hip_atomic_fetch_add(ss3l + lrow, s2, __ATOMIC_RELAXED, __HIP_MEMORY_SCOPE_WORKGROUP);
            }
        }
    }
};

__device__ __forceinline__ void transpose_w(const float* W, const float* scale, bf16_t* WT, int K, int N, int gt, int NT) {
    const int total = N * (K / 8);
    for (int idx = gt; idx < total; idx += NT) {
        const int n = idx % N, k0 = (idx / N) * 8;
        float v[8];
#pragma unroll
        for (int j = 0; j < 8; ++j) { v[j] = W[(size_t)(k0 + j) * N + n]; if (scale) v[j] *= scale[k0 + j]; }
        u32x4 w; w.x = pk2(v[0], v[1]); w.y = pk2(v[2], v[3]); w.z = pk2(v[4], v[5]); w.w = pk2(v[6], v[7]);
        *(u32x4*)(WT + (size_t)n * K + k0) = w;
    }
}
__device__ __forceinline__ void phase_prep(const Params& P) {
    const int tid = threadIdx.x, wave = tid >> 6, lane = tid & 63;
    const int gw = blockIdx.x * 8 + wave, NGW = gridDim.x * 8;
    const int gt = blockIdx.x * 512 + tid, NT = gridDim.x * 512;
    unsigned char* ws = P.ws;
    bf16_t* xb = (bf16_t*)(ws + OFF_XB);
    float* rstd1 = (float*)(ws + OFF_RSTD1);
    for (int row = gw; row < NTOK; row += 2 * NGW) {
        const int row2 = row + NGW;
        const f32x4* xr = (const f32x4*)(P.x + (size_t)row * 1024) + lane;
        const f32x4* xr2 = (const f32x4*)(P.x + (size_t)row2 * 1024) + lane;
        f32x4 v[4], v2[4]; float s = 0.f, s2 = 0.f;
#pragma unroll
        for (int j = 0; j < 4; ++j) { v[j] = xr[64 * j]; v2[j] = xr2[64 * j]; }
#pragma unroll
        for (int j = 0; j < 4; ++j) { s += v[j][0] * v[j][0] + v[j][1] * v[j][1] + v[j][2] * v[j][2] + v[j][3] * v[j][3];
                                      s2 += v2[j][0] * v2[j][0] + v2[j][1] * v2[j][1] + v2[j][2] * v2[j][2] + v2[j][3] * v2[j][3]; }
        s = wave_sum(s); s2 = wave_sum(s2);
        const float rs = rsqrtf(s * (1.0f / 1024.0f) + EPS), rs2 = rsqrtf(s2 * (1.0f / 1024.0f) + EPS);
        u32x2* o = (u32x2*)(xb + (size_t)row * 1024) + lane;
        u32x2* o2 = (u32x2*)(xb + (size_t)row2 * 1024) + lane;
#pragma unroll
        for (int j = 0; j < 4; ++j) { u32x2 w; w.x = pk2(v[j][0] * rs, v[j][1] * rs); w.y = pk2(v[j][2] * rs, v[j][3] * rs); o[64 * j] = w;
                                      u32x2 w2; w2.x = pk2(v2[j][0] * rs2, v2[j][1] * rs2); w2.y = pk2(v2[j][2] * rs2, v2[j][3] * rs2); o2[64 * j] = w2; }
    }
    bf16_t* pb = (bf16_t*)(ws + OFF_PB);
    for (int row = gw; row < NTOK; row += NGW) {
        const f32x4 v = ((const f32x4*)(P.p + (size_t)row * 256))[lane];
        u32x2 w; w.x = pk2(v[0], v[1]); w.y = pk2(v[2], v[3]);
        ((u32x2*)(pb + (size_t)row * 256))[lane] = w;
    }
    transpose_w(P.w_in, P.ln_mix, (bf16_t*)(ws + OFF_W1T), 1024, 4608, gt, NT);
    transpose_w(P.w_out, nullptr, (bf16_t*)(ws + OFF_W2T), 1024, 1024, gt, NT);
    transpose_w(P.w_pg, P.ln_ple, (bf16_t*)(ws + OFF_W3T), 1024, 1024, gt, NT);
    transpose_w(P.w_pp, nullptr, (bf16_t*)(ws + OFF_W4T), 256, 1024, gt, NT);
    float* lb = (float*)(ws + OFF_LB);
    for (int i = gt; i < 1024; i += NT) lb[i] = sigmoidf_(P.lb_logits[i] - P.lb_logits[1024 + i]);
    float* ss2 = (float*)(ws + OFF_SS2); float* ss3 = (float*)(ws + OFF_SS3);
    for (int i = gt; i < NTOK; i += NT) { ss2[i] = 0.f; ss3[i] = 0.f; }
}

constexpr int HS_LD = 136, HS_LD64 = 72;
constexpr int L_QT = 0, L_QH = 17408, L_KH = 34816, L_KT = 52224, L_VTT = 70656, L_P = 79872, L_ST = 89088, L_SEG = 106496, L_ETOT = 110592;
#define MFMA32(a, b, c) __builtin_amdgcn_mfma_f32_32x32x16_bf16((a), (b), (c), 0, 0, 0)
#define MFMA16(a, b, c) __builtin_amdgcn_mfma_f32_16x16x32_bf16((a), (b), (c), 0, 0, 0)

__device__ __forceinline__ void hgrn_scan_task(const Params& P, LAS unsigned char* lds, int task) {
    const int tid = threadIdx.x, w = __builtin_amdgcn_readfirstlane(tid >> 6), lane = tid & 63;
    const int half = task & 1, h = (task >> 1) & 3, b = (task >> 3) & 15, dir = task >> 7;
    LAS unsigned* QT32 = (LAS unsigned*)(lds + L_QT); LAS unsigned* QH32 = (LAS unsigned*)(lds + L_QH); LAS unsigned* KH32 = (LAS unsigned*)(lds + L_KH);
    LAS bf16_t* QT = (LAS bf16_t*)(lds + L_QT); LAS bf16_t* QH = (LAS bf16_t*)(lds + L_QH); LAS bf16_t* KH = (LAS bf16_t*)(lds + L_KH);
    LAS bf16_t* KT = (LAS bf16_t*)(lds + L_KT); LAS bf16_t* VTT = (LAS bf16_t*)(lds + L_VTT); LAS bf16_t* PL = (LAS bf16_t*)(lds + L_P);
    LAS bf16_t* ST = (LAS bf16_t*)(lds + L_ST); LAS float* SEG = (LAS float*)(lds + L_SEG); LAS float* ETOT = (LAS float*)(lds + L_ETOT);
    const bf16_t* G = (const bf16_t*)(P.ws + OFF_GF + (size_t)dir * 64 * MiB);
    const bf16_t* HQ = (const bf16_t*)(P.ws + OFF_HQ);
    const bf16_t* HIT = (const bf16_t*)(P.ws + OFF_HIT);
    bf16_t* OD = (bf16_t*)(P.ws + OFF_OD + (size_t)dir * 64 * MiB);
    for (int i = tid; i < 64 * HS_LD / 2; i += 512) ((LAS unsigned*)ST)[i] = 0u;
    f32x16 sacc;
#pragma unroll
    for (int i = 0; i < 16; ++i) sacc[i] = 0.f;
    const size_t tokbase = (size_t)b * 4096;
    const int r = lane & 31, hh = lane >> 5;
    const char* g_u = (const char*)G + (tokbase + 8 * w) * 1024 + h * 256;
    const char* q_u = (const char*)HQ + (tokbase + 8 * w) * 1024 + h * 256;
    const char* v_u = (const char*)HIT + ((size_t)((b * 4 + h) * 128 + half * 64)) * 8192;
    const unsigned gq_off = 4u * lane, v_off = (unsigned)(tid >> 3) * 8192u + (unsigned)(tid & 7) * 16u;
    unsigned gr[8], qr[8]; u32x4 vr;
#define HS_LOAD(c) do { const char* gc_ = g_u + (size_t)(c) * 65536; const char* qc_ = q_u + (size_t)(c) * 65536; \
        _Pragma("unroll") for (int i = 0; i < 8; ++i) { gr[i] = *(const unsigned*)(gc_ + i * 1024 + gq_off); qr[i] = *(const unsigned*)(qc_ + i * 1024 + gq_off); } \
        vr = *(const u32x4*)(v_u + (size_t)(c) * 128 + v_off); } while (0)
    { const int c0 = dir ? 63 : 0; HS_LOAD(c0); }
    for (int ci = 0; ci < 64; ++ci) {
        const int c = dir ? 63 - ci : ci;
        float g0[8], g1[8], bl0[8], bl1[8];
#pragma unroll
        for (int i = 0; i < 8; ++i) { g0[i] = bf_lo(gr[i]); g1[i] = bf_hi(gr[i]); }
        float a0 = 0.f, a1 = 0.f;
        if (dir == 0) {
#pragma unroll
            for (int i = 0; i < 8; ++i) { a0 += g0[i]; a1 += g1[i]; bl0[i] = a0; bl1[i] = a1; }
        } else {
#pragma unroll
            for (int i = 7; i >= 0; --i) { a0 += g0[i]; a1 += g1[i]; bl0[i] = a0; bl1[i] = a1; }
        }
        *(LAS f32x2*)(SEG + w * 128 + 2 * lane) = (f32x2){a0, a1};
        LDS_BAR();
        float off0 = 0.f, off1 = 0.f, ref0 = 0.f, ref1 = 0.f, tot0 = 0.f, tot1 = 0.f;
#pragma unroll
        for (int w2 = 0; w2 < 8; ++w2) {
            const f32x2 sv = *(const LAS f32x2*)(SEG + w2 * 128 + 2 * lane);
            tot0 += sv[0]; tot1 += sv[1];
            const bool before = dir == 0 ? (w2 < w) : (w2 > w);
            const bool inref = dir == 0 ? (w2 < 4) : (w2 >= 4);
            if (before) { off0 += sv[0]; off1 += sv[1]; }
            if (inref) { ref0 += sv[0]; ref1 += sv[1]; }
        }
        float kta[8], ktb[8];
        const float er0 = __builtin_amdgcn_exp2f(ref0), er1 = __builtin_amdgcn_exp2f(ref1), et0 = __builtin_amdgcn_exp2f(tot0 - ref0), et1 = __builtin_amdgcn_exp2f(tot1 - ref1);
#pragma unroll
        for (int i = 0; i < 8; ++i) {
            const int t = 8 * w + i;
            const float b0 = off0 + bl0[i], b1 = off1 + bl1[i];
            const float q0 = bf_lo(qr[i]), q1 = bf_hi(qr[i]);
            const float k0 = 1.0f - __builtin_amdgcn_exp2f(g0[i]), k1 = 1.0f - __builtin_amdgcn_exp2f(g1[i]);
            const float qh0 = q0 * __builtin_amdgcn_exp2f(fminf(b0 - ref0, 115.f)), qh1 = q1 * __builtin_amdgcn_exp2f(fminf(b1 - ref1, 115.f));
            const float kh0 = k0 * __builtin_amdgcn_exp2f(fminf(ref0 - b0, 115.f)), kh1 = k1 * __builtin_amdgcn_exp2f(fminf(ref1 - b1, 115.f));
            QT32[t * (HS_LD / 2) + lane] = pk2(qh0 * er0, qh1 * er1);
            QH32[t * (HS_LD / 2) + lane] = pk2(qh0, qh1);
            KH32[t * (HS_LD / 2) + lane] = pk2(kh0, kh1);
            kta[i] = kh0 * et0; ktb[i] = kh1 * et1;
        }
        { u32x4 wa, wb; wa.x = pk2(kta[0], kta[1]); wa.y = pk2(kta[2], kta[3]); wa.z = pk2(kta[4], kta[5]); wa.w = pk2(kta[6], kta[7]);
          wb.x = pk2(ktb[0], ktb[1]); wb.y = pk2(ktb[2], ktb[3]); wb.z = pk2(ktb[4], ktb[5]); wb.w = pk2(ktb[6], ktb[7]);
          *(LAS u32x4*)(KT + (2 * lane) * HS_LD64 + 8 * w) = wa; *(LAS u32x4*)(KT + (2 * lane + 1) * HS_LD64 + 8 * w) = wb; }
        *(LAS u32x4*)(VTT + (tid >> 3) * HS_LD64 + (tid & 7) * 8) = vr;
        if (w == 0) { *(LAS f32x2*)(ETOT + 2 * lane) = (f32x2){__builtin_amdgcn_exp2f(tot0), __builtin_amdgcn_exp2f(tot1)}; }
        LDS_BAR();
        if (ci + 1 < 64) { const int cn = dir ? 62 - ci : ci + 1; HS_LOAD(cn); }
        f32x16 o;
#pragma unroll
        for (int i = 0; i < 16; ++i) o[i] = 0.f;
        const int ti = (w >> 1) & 1, di = w & 1;
        if (w < 4) {
            const int si = w >> 1, tj = w & 1;
            f32x16 sc;
#pragma unroll
            for (int i = 0; i < 16; ++i) sc[i] = 0.f;
#pragma unroll
            for (int ks = 0; ks < 8; ++ks) {
                const bf16x8 a = *(const LAS bf16x8*)(KH + (32 * si + r) * HS_LD + 16 * ks + 8 * hh);
                const bf16x8 bq = *(const LAS bf16x8*)(QH + (32 * tj + r) * HS_LD + 16 * ks + 8 * hh);
                sc = MFMA32(a, bq, sc);
            }
            const int t = 32 * tj + r;
#pragma unroll
            for (int q4 = 0; q4 < 4; ++q4) {
                const int s0 = 32 * si + 8 * q4 + 4 * hh;
                float pv[4];
#pragma unroll
                for (int e = 0; e < 4; ++e) { const int s = s0 + e; const bool keep = dir == 0 ? (s <= t) : (s >= t); pv[e] = keep ? sc[4 * q4 + e] : 0.f; }
                u32x2 wv; wv.x = pk2(pv[0], pv[1]); wv.y = pk2(pv[2], pv[3]);
                *(LAS u32x2*)(PL + t * HS_LD64 + s0) = wv;
            }
        } else {
#pragma unroll
            for (int ks = 0; ks < 8; ++ks) {
                const bf16x8 a = *(const LAS bf16x8*)(QT + (32 * ti + r) * HS_LD + 16 * ks + 8 * hh);
                const bf16x8 bs = *(const LAS bf16x8*)(ST + (32 * di + r) * HS_LD + 16 * ks + 8 * hh);
                o = MFMA32(a, bs, o);
            }
        }
        LDS_BAR();
        if (w >= 4) {
#pragma unroll
            for (int ks = 0; ks < 4; ++ks) {
                const bf16x8 a = *(const LAS bf16x8*)(PL + (32 * ti + r) * HS_LD64 + 16 * ks + 8 * hh);
                const bf16x8 bv = *(const LAS bf16x8*)(VTT + (32 * di + r) * HS_LD64 + 16 * ks + 8 * hh);
                o = MFMA32(a, bv, o);
            }
            char* o_u = (char*)OD + (tokbase + 64 * c + 32 * ti) * 1024 + (h * 128 + half * 64 + 32 * di) * 2;
            const unsigned o_off = (unsigned)hh * 4096u + 2u * (unsigned)r;
#pragma unroll
            for (int i = 0; i < 16; ++i) { const int tr = (i & 3) + 8 * (i >> 2); *(bf16_t*)(o_u + tr * 1024 + o_off) = (bf16_t)(pk2(o[i], 0.f) & 0xffffu); }
        }
        {
            const int ki = w >> 1, dj = w & 1;
#pragma unroll
            for (int q4 = 0; q4 < 4; ++q4) {
                const f32x4 et = *(const LAS f32x4*)(ETOT + 32 * ki + 8 * q4 + 4 * hh);
#pragma unroll
                for (int e = 0; e < 4; ++e) sacc[4 * q4 + e] *= et[e];
            }
#pragma unroll
            for (int ks = 0; ks < 4; ++ks) {
                const bf16x8 a = *(const LAS bf16x8*)(KT + (32 * ki + r) * HS_LD64 + 16 * ks + 8 * hh);
                const bf16x8 bv = *(const LAS bf16x8*)(VTT + (32 * dj + r) * HS_LD64 + 16 * ks + 8 * hh);
                sacc = MFMA32(a, bv, sacc);
            }
#pragma unroll
            for (int q4 = 0; q4 < 4; ++q4) {
                u32x2 wv; wv.x = pk2(sacc[4 * q4], sacc[4 * q4 + 1]); wv.y = pk2(sacc[4 * q4 + 2], sacc[4 * q4 + 3]);
                *(LAS u32x2*)(ST + (32 * dj + r) * HS_LD + 32 * ki + 8 * q4 + 4 * hh) = wv;
            }
        }
    }
    LDS_BAR();
#undef HS_LOAD
}

constexpr int S2_LD = 136, S2_LDC = 40;
constexpr int S2_BUF = 41984, S2_QT = 0, S2_QH = 8704, S2_KH = 17408, S2_KT = 26112, S2_VT = 36352;
constexpr int S2_ETOT = 83968, S2_P = 84992, S2_ST = 87552, S2_SEG = 104960;
template <int DIR>
__device__ __forceinline__ void hgrn_scan2(const Params& P, LAS unsigned char* lds, int task) {
    const int tid = threadIdx.x, w = __builtin_amdgcn_readfirstlane(tid >> 6), lane = tid & 63;
    const int half = task & 1, h = (task >> 1) & 3, b = (task >> 3) & 15;
    const bf16_t* G = (const bf16_t*)(P.ws + OFF_GF + (size_t)DIR * 64 * MiB);
    const bf16_t* HQ = (const bf16_t*)(P.ws + OFF_HQ);
    const bf16_t* HIT = (const bf16_t*)(P.ws + OFF_HIT);
    bf16_t* OD = (bf16_t*)(P.ws + OFF_OD + (size_t)DIR * 64 * MiB);
    const size_t tokbase = (size_t)b * 4096;
    LAS bf16_t* ST = (LAS bf16_t*)(lds + S2_ST); LAS bf16_t* PL = (LAS bf16_t*)(lds + S2_P);
    LAS float* SEG = (LAS float*)(lds + S2_SEG);
    for (int i = tid; i < 64 * S2_LD / 2; i += 512) ((LAS unsigned*)ST)[i] = 0u;
    const int r = lane & 31, hh = lane >> 5;
    if (w < 4) {
        const char* g_u = (const char*)G + (tokbase + 8 * w) * 1024 + h * 256;
        const char* q_u = (const char*)HQ + (tokbase + 8 * w) * 1024 + h * 256;
        const char* v_u = (const char*)HIT + ((size_t)((b * 4 + h) * 128 + half * 64)) * 8192;
        const unsigned gq_off = 4u * lane, v_off = (unsigned)(tid >> 2) * 8192u + (unsigned)(tid & 3) * 16u;
        unsigned gA[8], qA[8], gB[8], qB[8]; u32x4 vA, vB;
#define S2_LOAD(gr, qr, vr, s_) do { const int c_ = DIR ? 127 - (s_) : (s_); const char* gc_ = g_u + (size_t)c_ * 32768; const char* qc_ = q_u + (size_t)c_ * 32768; \
        _Pragma("unroll") for (int i = 0; i < 8; ++i) { gr[i] = *(const unsigned*)(gc_ + i * 1024 + gq_off); qr[i] = *(const unsigned*)(qc_ + i * 1024 + gq_off); } \
        vr = *(const u32x4*)(v_u + (size_t)c_ * 64 + v_off); } while (0)
#define S2_PRODUCE(gr, qr, vr, s_) do { \
          \
        LAS unsigned char* bufp = lds + ((s_) & 1) * S2_BUF; \
        *(LAS u32x4*)((LAS bf16_t*)(bufp + S2_VT) + (tid >> 2) * S2_LDC + (tid & 3) * 8) = vr; \
        float qe0[8], qe1[8], ke0[8], ke1[8]; \
        float a0 = 0.f, a1 = 0.f, p0 = 1.f, p1 = 1.f; \
        _Pragma("unroll") for (int ii = 0; ii < 8; ++ii) { \
            const int i = DIR == 0 ? ii : 7 - ii; \
            const float gg0 = bf_lo(gr[i]), gg1 = bf_hi(gr[i]), q0 = bf_lo(qr[i]), q1 = bf_hi(qr[i]); \
            a0 += gg0; a1 += gg1; \
            const float f0 = __builtin_amdgcn_exp2f(gg0), f1 = __builtin_amdgcn_exp2f(gg1); \
            p0 *= f0; p1 *= f1; \
            qe0[i] = q0 * p0; qe1[i] = q1 * p1; \
            ke0[i] = (1.0f - f0) * __builtin_amdgcn_exp2f(-a0); ke1[i] = (1.0f - f1) * __builtin_amdgcn_exp2f(-a1); } \
        if ((s_) + 2 < 128) S2_LOAD(gr, qr, vr, (s_) + 2); \
        *(LAS f32x2*)(SEG + w * 128 + 2 * lane) = (f32x2){a0, a1}; \
        LDS_BAR(); \
        float off0 = 0.f, off1 = 0.f, ref0 = 0.f, ref1 = 0.f, tot0 = 0.f, tot1 = 0.f; \
        _Pragma("unroll") for (int w2 = 0; w2 < 4; ++w2) { \
            const f32x2 sv = *(const LAS f32x2*)(SEG + w2 * 128 + 2 * lane); \
            tot0 += sv[0]; tot1 += sv[1]; \
            if (DIR == 0 ? (w2 < w) : (w2 > w)) { off0 += sv[0]; off1 += sv[1]; } \
            if (DIR == 0 ? (w2 < 2) : (w2 >= 2)) { ref0 += sv[0]; ref1 += sv[1]; } } \
        const float A0 = __builtin_amdgcn_exp2f(off0 - ref0), A1 = __builtin_amdgcn_exp2f(off1 - ref1); \
        const float B0 = __builtin_amdgcn_exp2f(ref0 - off0), B1 = __builtin_amdgcn_exp2f(ref1 - off1); \
        const float AQ0 = __builtin_amdgcn_exp2f(off0), AQ1 = __builtin_amdgcn_exp2f(off1); \
        const float BK0 = __builtin_amdgcn_exp2f(tot0 - off0), BK1 = __builtin_amdgcn_exp2f(tot1 - off1); \
        _Pragma("unroll") for (int i = 0; i < 8; ++i) { \
            const int t = 8 * w + i; \
            ((LAS unsigned*)(bufp + S2_QT))[t * (S2_LD / 2) + lane] = pk2(qe0[i] * AQ0, qe1[i] * AQ1); \
            ((LAS unsigned*)(bufp + S2_QH))[t * (S2_LD / 2) + lane] = pk2(qe0[i] * A0, qe1[i] * A1); \
            ((LAS unsigned*)(bufp + S2_KH))[t * (S2_LD / 2) + lane] = pk2(ke0[i] * B0, ke1[i] * B1); } \
        { u32x4 wa, wb; wa.x = pk2(ke0[0] * BK0, ke0[1] * BK0); wa.y = pk2(ke0[2] * BK0, ke0[3] * BK0); wa.z = pk2(ke0[4] * BK0, ke0[5] * BK0); wa.w = pk2(ke0[6] * BK0, ke0[7] * BK0); \
          wb.x = pk2(ke1[0] * BK1, ke1[1] * BK1); wb.y = pk2(ke1[2] * BK1, ke1[3] * BK1); wb.z = pk2(ke1[4] * BK1, ke1[5] * BK1); wb.w = pk2(ke1[6] * BK1, ke1[7] * BK1); \
          *(LAS u32x4*)((LAS bf16_t*)(bufp + S2_KT) + (2 * lane) * S2_LDC + 8 * w) = wa; *(LAS u32x4*)((LAS bf16_t*)(bufp + S2_KT) + (2 * lane + 1) * S2_LDC + 8 * w) = wb; } \
        if (w == 0) *(LAS f32x2*)((LAS float*)(lds + S2_ETOT) + ((s_) & 1) * 128 + 2 * lane) = (f32x2){__builtin_amdgcn_exp2f(tot0), __builtin_amdgcn_exp2f(tot1)}; \
        LDS_BAR(); } while (0)
        S2_LOAD(gA, qA, vA, 0); S2_LOAD(gB, qB, vB, 1);
        for (int s = 0; s < 128; s += 2) { S2_PRODUCE(gA, qA, vA, s); S2_PRODUCE(gB, qB, vB, s + 1); }
        LDS_BAR(); LDS_BAR();
#undef S2_LOAD
#undef S2_PRODUCE
    } else {
        const int wb = w - 4;
        f32x16 sacc0, sacc1;
#pragma unroll
        for (int i = 0; i < 16; ++i) { sacc0[i] = 0.f; sacc1[i] = 0.f; }
        LDS_BAR(); LDS_BAR();
        for (int s = 1; s <= 128; ++s) {
            const int cs = s - 1, c = DIR ? 127 - cs : cs;
            const LAS unsigned char* bufp = lds + (cs & 1) * S2_BUF;
            const LAS bf16_t* QT = (const LAS bf16_t*)(bufp + S2_QT); const LAS bf16_t* QH = (const LAS bf16_t*)(bufp + S2_QH); const LAS bf16_t* KH = (const LAS bf16_t*)(bufp + S2_KH);
            const LAS bf16_t* KT = (const LAS bf16_t*)(bufp + S2_KT); const LAS bf16_t* VTT = (const LAS bf16_t*)(bufp + S2_VT);
            const LAS float* ETOT = (const LAS float*)(lds + S2_ETOT) + (cs & 1) * 128;
            f32x16 o, o2;
#pragma unroll
            for (int i = 0; i < 16; ++i) { o[i] = 0.f; o2[i] = 0.f; }
            const int di = (wb - 1) & 1;
            if (wb == 0) {
#pragma unroll
                for (int ks = 0; ks < 8; ks += 2) {
                    o = MFMA32(*(const LAS bf16x8*)(KH + r * S2_LD + 16 * ks + 8 * hh), *(const LAS bf16x8*)(QH + r * S2_LD + 16 * ks + 8 * hh), o);
                    o2 = MFMA32(*(const LAS bf16x8*)(KH + r * S2_LD + 16 * (ks + 1) + 8 * hh), *(const LAS bf16x8*)(QH + r * S2_LD + 16 * (ks + 1) + 8 * hh), o2);
                }
#pragma unroll
                for (int q4 = 0; q4 < 4; ++q4) {
                    const int s0 = 8 * q4 + 4 * hh;
                    float pv[4];
#pragma unroll
                    for (int e = 0; e < 4; ++e) { const int sr = s0 + e; const bool keep = DIR == 0 ? (sr <= r) : (sr >= r); pv[e] = keep ? (o[4 * q4 + e] + o2[4 * q4 + e]) : 0.f; }
                    u32x2 wv; wv.x = pk2(pv[0], pv[1]); wv.y = pk2(pv[2], pv[3]);
                    *(LAS u32x2*)(PL + r * S2_LDC + s0) = wv;
                }
            } else if (wb < 3) {
#pragma unroll
                for (int ks = 0; ks < 8; ks += 2) {
                    o = MFMA32(*(const LAS bf16x8*)(QT + r * S2_LD + 16 * ks + 8 * hh), *(const LAS bf16x8*)(ST + (32 * di + r) * S2_LD + 16 * ks + 8 * hh), o);
                    o2 = MFMA32(*(const LAS bf16x8*)(QT + r * S2_LD + 16 * (ks + 1) + 8 * hh), *(const LAS bf16x8*)(ST + (32 * di + r) * S2_LD + 16 * (ks + 1) + 8 * hh), o2);
                }
            }
            LDS_BAR();
            if (wb == 1 || wb == 2) {
                o = MFMA32(*(const LAS bf16x8*)(PL + r * S2_LDC + 8 * hh), *(const LAS bf16x8*)(VTT + (32 * di + r) * S2_LDC + 8 * hh), o);
                o2 = MFMA32(*(const LAS bf16x8*)(PL + r * S2_LDC + 16 + 8 * hh), *(const LAS bf16x8*)(VTT + (32 * di + r) * S2_LDC + 16 + 8 * hh), o2);
                char* o_u = (char*)OD + (tokbase + 32 * c) * 1024 + (h * 128 + half * 64 + 32 * di) * 2;
                const unsigned o_off = (unsigned)hh * 4096u + 2u * (unsigned)r;
#pragma unroll
                for (int i = 0; i < 16; ++i) { const int tr = (i & 3) + 8 * (i >> 2); *(bf16_t*)(o_u + tr * 1024 + o_off) = (bf16_t)(pk2(o[i] + o2[i], 0.f) & 0xffffu); }
            }
            {
#pragma unroll
                for (int q4 = 0; q4 < 4; ++q4) {
                    const f32x4 et = *(const LAS f32x4*)(ETOT + 32 * wb + 8 * q4 + 4 * hh);
#pragma unroll
                    for (int e = 0; e < 4; ++e) { sacc0[4 * q4 + e] *= et[e]; sacc1[4 * q4 + e] *= et[e]; }
                }
#pragma unroll
                for (int ks = 0; ks < 2; ++ks) {
                    const bf16x8 a = *(const LAS bf16x8*)(KT + (32 * wb + r) * S2_LDC + 16 * ks + 8 * hh);
                    sacc0 = MFMA32(a, *(const LAS bf16x8*)(VTT + r * S2_LDC + 16 * ks + 8 * hh), sacc0);
                    sacc1 = MFMA32(a, *(const LAS bf16x8*)(VTT + (32 + r) * S2_LDC + 16 * ks + 8 * hh), sacc1);
                }
#pragma unroll
                for (int q4 = 0; q4 < 4; ++q4) {
                    u32x2 w0, w1; w0.x = pk2(sacc0[4 * q4], sacc0[4 * q4 + 1]); w0.y = pk2(sacc0[4 * q4 + 2], sacc0[4 * q4 + 3]);
                    w1.x = pk2(sacc1[4 * q4], sacc1[4 * q4 + 1]); w1.y = pk2(sacc1[4 * q4 + 2], sacc1[4 * q4 + 3]);
                    *(LAS u32x2*)(ST + r * S2_LD + 32 * wb + 8 * q4 + 4 * hh) = w0;
                    *(LAS u32x2*)(ST + (32 + r) * S2_LD + 32 * wb + 8 * q4 + 4 * hh) = w1;
                }
            }
            LDS_BAR();
        }
    }
    LDS_BAR();
}

constexpr int AT_K = 0, AT_V = 61440, AT_RP = 122880 + 256;
__device__ __forceinline__ void phase_attn(const Params& P, LAS unsigned char* lds) {
    const int tid = threadIdx.x, wave = __builtin_amdgcn_readfirstlane(tid >> 6), lane = tid & 63;
    const int qi = lane & 15, g = lane >> 4;
    const bf16_t* Q = (const bf16_t*)(P.ws + OFF_Q); const bf16_t* Kp = (const bf16_t*)(P.ws + OFF_K);
    const bf16_t* VT = (const bf16_t*)(P.ws + OFF_VT); const bf16_t* SG = (const bf16_t*)(P.ws + OFF_SG);
    bf16_t* mix = (bf16_t*)(P.ws + OFF_MIX);
    LAS float* rpl = (LAS float*)(lds + AT_RP);
    const int jrow = 8 * (qi >> 2) + (qi & 3);
    u32x4 pk_[8], pv_[8];
#define AT_ISSUE(rnd_) do { const int h_ = (rnd_) & 7, n_ = ((rnd_) >> 3) & 3, rh_ = ((rnd_) >> 5) & 7, b_ = (rnd_) >> 8; \
        const int R0_ = min(max(8 * rh_ - 4, 0), 49), bs_ = min(max(16 * n_ - 8, 0), 32); \
        const bf16_t* kt_ = Kp + ((size_t)(b_ * 8 + h_) * 4096 + R0_ * 64 + bs_) * 64; \
        const bf16_t* vt_ = VT + ((size_t)(b_ * 8 + h_) * 64 + R0_) * 4096 + bs_; \
        _Pragma("unroll") for (int i = 0; i < 8; ++i) { const int q = tid + 512 * i; if (q < 3840) { \
            pk_[i] = *(const u32x4*)(kt_ + (q >> 8) * 4096 + ((q >> 3) & 31) * 64 + (q & 7) * 8); \
            pv_[i] = *(const u32x4*)(vt_ + (q >> 8) * 4096 + ((q >> 2) & 63) * 64 + (q & 3) * 8); } } } while (0)
    bf16x8 qn[2]; u32x2 gn[4];
#define AT_ISSUE_Q(rnd_) do { const int h_ = (rnd_) & 7, n_ = ((rnd_) >> 3) & 3, rr_ = (((rnd_) >> 5) & 7) * 8 + wave, b_ = (rnd_) >> 8; \
        const bf16_t* qq_ = Q + ((size_t)(b_ * 8 + h_) * 4096 + rr_ * 64 + 16 * n_) * 64 + qi * 64 + 8 * g; \
        const bf16_t* sg_ = SG + ((size_t)b_ * 4096 + rr_ * 64 + 16 * n_) * 512 + h_ * 64 + qi * 512 + 4 * g; \
        qn[0] = *(const bf16x8*)qq_; qn[1] = *(const bf16x8*)(qq_ + 32); \
        gn[0] = *(const u32x2*)sg_; gn[1] = *(const u32x2*)(sg_ + 16); gn[2] = *(const u32x2*)(sg_ + 32); gn[3] = *(const u32x2*)(sg_ + 48); } while (0)
    int rnd = blockIdx.x;
    if (rnd < 4096) { AT_ISSUE(rnd); AT_ISSUE_Q(rnd); }
    for (; rnd < 4096; rnd += gridDim.x) {
        const int h = rnd & 7, n = (rnd >> 3) & 3, rh = (rnd >> 5) & 7, b = rnd >> 8;
        const int R0 = min(max(8 * rh - 4, 0), 49), bs = min(max(16 * n - 8, 0), 32);
        LDS_BAR();
#pragma unroll
        for (int i = 0; i < 8; ++i) { const int q = tid + 512 * i; if (q < 3840) {
            const int col = (q >> 3) & 31, d = (q >> 2) & 63;
            *(LAS u32x4*)(lds + AT_K + ((q >> 8) * 32 + col) * 128 + (((q & 7) ^ (((col >> 1) & 1) | (((col >> 3) & 3) << 1))) * 16)) = pk_[i];
            *(LAS u32x4*)(lds + AT_V + ((q >> 8) * 64 + d) * 64 + (((q & 3) ^ ((d >> 2) & 3)) * 16)) = pv_[i]; } }
        if (tid < 465) rpl[tid] = P.rpb[h * 465 + tid] * 1.4426950408889634f;
        LDS_BAR();
        const bf16x8 qf[2] = {qn[0], qn[1]};
        const u32x2 gw2[4] = {gn[0], gn[1], gn[2], gn[3]};
        { const int nx = rnd + gridDim.x; if (nx < 4096) { AT_ISSUE(nx); AT_ISSUE_Q(nx); } }
        const int rr = 8 * rh + wave;
        const int rs = min(max(rr - 4, 0), 56), lrow0 = rs - R0;
        const int qc = 16 * n + qi, cs = min(max(qc - 8, 0), 48);
        bf16_t* mix_u = mix + ((size_t)b * 4096 + rr * 64 + 16 * n) * 1024 + h * 64;
        f32x4 sacc[16];
#pragma unroll
        for (int kb = 0; kb < 16; ++kb) {
            const int jc = jrow + 4 * (kb & 1);
            const LAS unsigned char* kr = lds + AT_K + ((lrow0 + (kb >> 1)) * 32 + jc) * 128;
            const int sw = ((jc >> 1) & 1) | (((jc >> 3) & 3) << 1);
            const bf16x8 k0 = *(const LAS bf16x8*)(kr + ((g ^ sw) * 16));
            const bf16x8 k1 = *(const LAS bf16x8*)(kr + (((4 + g) ^ sw) * 16));
            sacc[kb] = MFMA16(k0, qf[0], ((f32x4){0.f, 0.f, 0.f, 0.f}));
            sacc[kb] = MFMA16(k1, qf[1], sacc[kb]);
        }
        const LAS float* rp = rpl + (rs - rr + 7) * 31 + (bs + 8 * g - qc + 15);
        const int kc0 = bs + 8 * g;
        float mx = -INFINITY;
#pragma unroll
        for (int kb = 0; kb < 16; ++kb) {
#pragma unroll
            for (int j = 0; j < 4; ++j) {
                const int kc = kc0 + 4 * (kb & 1) + j;
                const bool valid = (kc >= cs) && (kc < cs + 16);
                float s = sacc[kb][j] + rp[(kb >> 1) * 31 + 4 * (kb & 1) + j];
                s = valid ? s : -INFINITY;
                sacc[kb][j] = s; mx = fmaxf(mx, s);
            }
        }
        mx = fmaxf(mx, __shfl_xor(mx, 16)); mx = fmaxf(mx, __shfl_xor(mx, 32));
        float sum = 0.f;
#pragma unroll
        for (int kb = 0; kb < 16; ++kb)
#pragma unroll
            for (int j = 0; j < 4; ++j) { const float pe = __builtin_amdgcn_exp2f(sacc[kb][j] - mx); sacc[kb][j] = pe; sum += pe; }
        sum += __shfl_xor(sum, 16); sum += __shfl_xor(sum, 32);
        f32x4 oacc[4];
#pragma unroll
        for (int db = 0; db < 4; ++db) oacc[db] = (f32x4){0.f, 0.f, 0.f, 0.f};
#pragma unroll
        for (int c = 0; c < 8; ++c) {
            u32x4 pw; pw.x = pk2(sacc[2 * c][0], sacc[2 * c][1]); pw.y = pk2(sacc[2 * c][2], sacc[2 * c][3]);
            pw.z = pk2(sacc[2 * c + 1][0], sacc[2 * c + 1][1]); pw.w = pk2(sacc[2 * c + 1][2], sacc[2 * c + 1][3]);
            const bf16x8 pf = __builtin_bit_cast(bf16x8, pw);
#pragma unroll
            for (int db = 0; db < 4; ++db) {
                const int d = db * 16 + qi;
                const bf16x8 vfr = *(const LAS bf16x8*)(lds + AT_V + ((lrow0 + c) * 64 + d) * 64 + ((g ^ ((d >> 2) & 3)) * 16));
                oacc[db] = MFMA16(vfr, pf, oacc[db]);
            }
        }
        const float inv = __builtin_amdgcn_rcpf(sum);
        float ssq = 0.f;
#pragma unroll
        for (int db = 0; db < 4; ++db)
#pragma unroll
            for (int j = 0; j < 4; ++j) { const float ov = oacc[db][j] * inv; oacc[db][j] = ov; ssq += ov * ov; }
        ssq += __shfl_xor(ssq, 16); ssq += __shfl_xor(ssq, 32);
        const float rn = rsqrtf(ssq * (1.0f / 64.0f) + EPS);
#pragma unroll
        for (int db = 0; db < 4; ++db) {
            const int col = h * 64 + db * 16 + 4 * g;
            const f32x4 an = *(const f32x4*)(P.attn_norm + col);
            u32x2 wv;
            wv.x = pk2(oacc[db][0] * rn * an[0] * siluf_(bf_lo(gw2[db].x)), oacc[db][1] * rn * an[1] * siluf_(bf_hi(gw2[db].x)));
            wv.y = pk2(oacc[db][2] * rn * an[2] * siluf_(bf_lo(gw2[db].y)), oacc[db][3] * rn * an[3] * siluf_(bf_hi(gw2[db].y)));
            *(u32x2*)(mix_u + db * 16 + qi * 1024 + 4 * g) = wv;
        }
    }
    __syncthreads();
#undef AT_ISSUE
#undef AT_ISSUE_Q
}

__device__ __forceinline__ void phase_hpost(const Params& P) {
    const int tid = threadIdx.x, wave = tid >> 6, lane = tid & 63;
    const int gw = blockIdx.x * 8 + wave, NGW = gridDim.x * 8;
    const bf16_t* O0 = (const bf16_t*)(P.ws + OFF_OD); const bf16_t* O1 = (const bf16_t*)(P.ws + OFF_OD + 64 * MiB);
    const bf16_t* SHG = (const bf16_t*)(P.ws + OFF_SHG);
    bf16_t* mix = (bf16_t*)(P.ws + OFF_MIX);
    const int c0 = 8 * lane;
    const f32x4 n0 = *(const f32x4*)(P.hgrn_norm + c0), n1 = *(const f32x4*)(P.hgrn_norm + c0 + 4);
    const float nw[8] = {n0[0], n0[1], n0[2], n0[3], n1[0], n1[1], n1[2], n1[3]};
    for (int tok = gw; tok < NTOK; tok += NGW) {
        const u32x4 a = *(const u32x4*)(O0 + (size_t)tok * 512 + c0), bq = *(const u32x4*)(O1 + (size_t)tok * 512 + c0), gt = *(const u32x4*)(SHG + (size_t)tok * 512 + c0);
        float v[8] = {bf_lo(a.x) + bf_lo(bq.x), bf_hi(a.x) + bf_hi(bq.x), bf_lo(a.y) + bf_lo(bq.y), bf_hi(a.y) + bf_hi(bq.y),
                      bf_lo(a.z) + bf_lo(bq.z), bf_hi(a.z) + bf_hi(bq.z), bf_lo(a.w) + bf_lo(bq.w), bf_hi(a.w) + bf_hi(bq.w)};
        const float gv[8] = {bf_lo(gt.x), bf_hi(gt.x), bf_lo(gt.y), bf_hi(gt.y), bf_lo(gt.z), bf_hi(gt.z), bf_lo(gt.w), bf_hi(gt.w)};
        float s = 0.f;
#pragma unroll
        for (int e = 0; e < 8; ++e) s += v[e] * v[e];
        s += __shfl_xor(s, 1); s += __shfl_xor(s, 2); s += __shfl_xor(s, 4); s += __shfl_xor(s, 8);
        const float rn = rsqrtf(s * (1.0f / 128.0f) + EPS);
#pragma unroll
        for (int e = 0; e < 8; ++e) v[e] = v[e] * rn * nw[e] * gv[e];
        u32x4 wv; wv.x = pk2(v[0], v[1]); wv.y = pk2(v[2], v[3]); wv.z = pk2(v[4], v[5]); wv.w = pk2(v[6], v[7]);
        *(u32x4*)(mix + (size_t)tok * 1024 + 512 + c0) = wv;
    }
}

__device__ __forceinline__ void phase_final(const Params& P) {
    const int tid = threadIdx.x, wave = tid >> 6, lane = tid & 63;
    const int gw = blockIdx.x * 8 + wave, NGW = gridDim.x * 8;
    const float* ss3 = (const float*)(P.ws + OFF_SS3);
    f32x4 lw[4];
#pragma unroll
    for (int j = 0; j < 4; ++j) lw[j] = ((const f32x4*)P.ln_final)[lane + 64 * j];
    for (int row = gw; row < NTOK; row += NGW) {
        const float rs = rsqrtf(ss3[row] * (1.0f / 1024.0f) + EPS);
        f32x4* o = (f32x4*)(P.out + (size_t)row * 1024) + lane;
#pragma unroll
        for (int j = 0; j < 4; ++j) { f32x4 v = o[64 * j]; v = v * rs * lw[j]; o[64 * j] = v; }
    }
}

#define BLOCK_HANDOFF() do { __builtin_amdgcn_fence(__ATOMIC_RELEASE, "workgroup"); __syncthreads(); __builtin_amdgcn_fence(__ATOMIC_ACQUIRE, "workgroup"); } while (0)
__device__ __forceinline__ void phase_tail(const Params& P, LAS unsigned char* lds) {
    const int tid = threadIdx.x, wave = __builtin_amdgcn_readfirstlane(tid >> 6), lane = tid & 63;
    LAS float* ss2l = (LAS float*)(lds + 131072); LAS float* ss3l = ss2l + 256;
    const bf16_t* O0 = (const bf16_t*)(P.ws + OFF_OD); const bf16_t* O1 = (const bf16_t*)(P.ws + OFF_OD + 64 * MiB);
    const bf16_t* SHG = (const bf16_t*)(P.ws + OFF_SHG);
    bf16_t* mix = (bf16_t*)(P.ws + OFF_MIX);
    {
        const int panel = blockIdx.x;
        __syncthreads();
        ss2l[tid] = 0.f;
        const bool odd = (blockIdx.x & 1) != 0;
        if (odd) { __syncthreads();
        {
            pg8::PanelOrder S{panel, 4};
            pg8::Gemm g{(const bf16_t*)(P.ws + OFF_PB), (const bf16_t*)(P.ws + OFF_W4T), NTOK, 1024, 256};
            EpiPP E{(bf16_t*)(P.ws + OFF_PP)};
            pg8::gemm_phase(lds, g, S, E);
        }
        }
        {
            const int c0 = 8 * lane;
            const f32x4 n0 = *(const f32x4*)(P.hgrn_norm + c0), n1 = *(const f32x4*)(P.hgrn_norm + c0 + 4);
            const float nw[8] = {n0[0], n0[1], n0[2], n0[3], n1[0], n1[1], n1[2], n1[3]};
#pragma unroll 8
            for (int i = 0; i < 32; ++i) {
                const size_t tok = (size_t)panel * 256 + wave * 32 + i;
                const u32x4 a = *(const u32x4*)(O0 + tok * 512 + c0), bq = *(const u32x4*)(O1 + tok * 512 + c0), gt = *(const u32x4*)(SHG + tok * 512 + c0);
                float v[8] = {bf_lo(a.x) + bf_lo(bq.x), bf_hi(a.x) + bf_hi(bq.x), bf_lo(a.y) + bf_lo(bq.y), bf_hi(a.y) + bf_hi(bq.y),
                              bf_lo(a.z) + bf_lo(bq.z), bf_hi(a.z) + bf_hi(bq.z), bf_lo(a.w) + bf_lo(bq.w), bf_hi(a.w) + bf_hi(bq.w)};
                const float gv[8] = {bf_lo(gt.x), bf_hi(gt.x), bf_lo(gt.y), bf_hi(gt.y), bf_lo(gt.z), bf_hi(gt.z), bf_lo(gt.w), bf_hi(gt.w)};
                float s = 0.f;
#pragma unroll
                for (int e = 0; e < 8; ++e) s += v[e] * v[e];
                s += __shfl_xor(s, 1); s += __shfl_xor(s, 2); s += __shfl_xor(s, 4); s += __shfl_xor(s, 8);
                const float rn = rsqrtf(s * (1.0f / 128.0f) + EPS);
#pragma unroll
                for (int e = 0; e < 8; ++e) v[e] = v[e] * rn * nw[e] * siluf_(gv[e]);
                u32x4 wv; wv.x = pk2(v[0], v[1]); wv.y = pk2(v[2], v[3]); wv.z = pk2(v[4], v[5]); wv.w = pk2(v[6], v[7]);
                *(u32x4*)(mix + tok * 1024 + 512 + c0) = wv;
            }
        }
        BLOCK_HANDOFF();
        {
            pg8::PanelOrder S{panel, 4};
            pg8::Gemm g{(const bf16_t*)(P.ws + OFF_MIX), (const bf16_t*)(P.ws + OFF_W2T), NTOK, 1024, 1024};
            Epi2P E{P.x, P.out, (bf16_t*)(P.ws + OFF_HB), ss2l};
            pg8::gemm_phase(lds, g, S, E);
        }
        if (!odd) {
        {
            pg8::PanelOrder S{panel, 4};
            pg8::Gemm g{(const bf16_t*)(P.ws + OFF_PB), (const bf16_t*)(P.ws + OFF_W4T), NTOK, 1024, 256};
            EpiPP E{(bf16_t*)(P.ws + OFF_PP)};
            pg8::gemm_phase(lds, g, S, E);
        }
        }
        BLOCK_HANDOFF();
        {
            pg8::PanelOrder S{panel, 4};
            pg8::Gemm g{(const bf16_t*)(P.ws + OFF_HB), (const bf16_t*)(P.ws + OFF_W3T), NTOK, 1024, 1024};
            Epi3P E{(bf16_t*)(P.ws + OFF_HFB), (const bf16_t*)(P.ws + OFF_PP), (const bf16_t*)(P.ws + OFF_HB), ss2l, ss3l};
            pg8::gemm_phase(lds, g, S, E);
        }
        BLOCK_HANDOFF();
        {
            const bf16_t* hfb = (const bf16_t*)(P.ws + OFF_HFB);
            f32x4 lw[4];
#pragma unroll
            for (int j = 0; j < 2; ++j) { lw[2 * j] = *(const f32x4*)(P.ln_final + lane * 8 + 512 * j); lw[2 * j + 1] = *(const f32x4*)(P.ln_final + lane * 8 + 512 * j + 4); }
#pragma unroll 8
            for (int i = 0; i < 32; ++i) {
                const int lrow = wave * 32 + i;
                const float rs = rsqrtf(ss3l[lrow] * (1.0f / 1024.0f) + EPS);
                const size_t ro = ((size_t)panel * 256 + lrow) * 1024 + lane * 8;
                const u32x4 a = *(const u32x4*)(hfb + ro), bq = *(const u32x4*)(hfb + ro + 512);
                f32x4 v0 = {bf_lo(a.x), bf_hi(a.x), bf_lo(a.y), bf_hi(a.y)}, v1 = {bf_lo(a.z), bf_hi(a.z), bf_lo(a.w), bf_hi(a.w)};
                f32x4 v2 = {bf_lo(bq.x), bf_hi(bq.x), bf_lo(bq.y), bf_hi(bq.y)}, v3 = {bf_lo(bq.z), bf_hi(bq.z), bf_lo(bq.w), bf_hi(bq.w)};
                *(f32x4*)(P.out + ro) = v0 * rs * lw[0]; *(f32x4*)(P.out + ro + 4) = v1 * rs * lw[1];
                *(f32x4*)(P.out + ro + 512) = v2 * rs * lw[2]; *(f32x4*)(P.out + ro + 516) = v3 * rs * lw[3];
            }
        }
    }
}

template <int PH> __device__ __forceinline__ void run_phase(const Params& P, LAS unsigned char* lds) {
    if constexpr (PH == 0) {
        phase_prep(P);
    } else if constexpr (PH == 1) {
        pg8::StaticOrder S; S.init(NTOK, 4608, (int)gridDim.x, (int)blockIdx.x);
        pg8::Gemm g{(const bf16_t*)(P.ws + OFF_XB), (const bf16_t*)(P.ws + OFF_W1T), NTOK, 4608, 1024};
        Epi1 E{P.ws};
        pg8::gemm_phase(lds, g, S, E);
    } else if constexpr (PH == 2) {
#ifndef SKIP_SCAN
        for (int task = blockIdx.x; task < 256; task += gridDim.x) { if (task >> 7) hgrn_scan2<1>(P, lds, task); else hgrn_scan2<0>(P, lds, task); }
#if PROBE_DUP == 20
        for (int task = blockIdx.x; task < 256; task += gridDim.x) { if (task >> 7) hgrn_scan2<1>(P, lds, task); else hgrn_scan2<0>(P, lds, task); }
#endif
#else
        { u32x4* od = (u32x4*)(P.ws + OFF_OD); for (size_t i = (size_t)blockIdx.x * 512 + threadIdx.x; i < (128 * MiB) / 16; i += (size_t)gridDim.x * 512) od[i] = (u32x4){0u, 0u, 0u, 0u}; }
#endif
        phase_attn(P, lds);
#if PROBE_DUP == 21
        phase_attn(P, lds);
#endif
    } else if constexpr (PH == 3) {
        phase_hpost(P);
        __syncthreads();
        pg8::StaticOrder S; S.init(NTOK, 1024, (int)gridDim.x, (int)blockIdx.x);
        pg8::Gemm g{(const bf16_t*)(P.ws + OFF_PB), (const bf16_t*)(P.ws + OFF_W4T), NTOK, 1024, 256};
        EpiPP E{(bf16_t*)(P.ws + OFF_PP)};
        pg8::gemm_phase(lds, g, S, E);
    } else if constexpr (PH == 4) {
        pg8::StaticOrder S; S.init(NTOK, 1024, (int)gridDim.x, (int)blockIdx.x);
        pg8::Gemm g{(const bf16_t*)(P.ws + OFF_MIX), (const bf16_t*)(P.ws + OFF_W2T), NTOK, 1024, 1024};
        Epi2 E{P.x, P.out, (bf16_t*)(P.ws + OFF_HB), (float*)(P.ws + OFF_SS2)};
        pg8::gemm_phase(lds, g, S, E);
    } else if constexpr (PH == 5) {
        pg8::StaticOrder S; S.init(NTOK, 1024, (int)gridDim.x, (int)blockIdx.x);
        pg8::Gemm g{(const bf16_t*)(P.ws + OFF_HB), (const bf16_t*)(P.ws + OFF_W3T), NTOK, 1024, 1024};
        Epi3 E{P.out, (const bf16_t*)(P.ws + OFF_PP), (const float*)(P.ws + OFF_SS2), (float*)(P.ws + OFF_SS3)};
        pg8::gemm_phase(lds, g, S, E);
    } else {
        phase_final(P);
    }
}
#if N_LAUNCHES == 1
__global__ __launch_bounds__(512, 2) void fwd_kernel(Params P) {
    extern __shared__ __attribute__((aligned(16))) unsigned char shm[];
    LAS unsigned char* lds = (LAS unsigned char*)shm;
    cg::grid_group grid = cg::this_grid();
    volatile LAS unsigned* xst = (volatile LAS unsigned*)(lds + 131072 + 2048);
    if (threadIdx.x == 0) { xst[0] = 0u; xst[1] = 0u; }
    __syncthreads();
    const XcdBarrier xb = xcd_barrier_post((unsigned*)(P.ws + OFF_BAR), xst);
    run_phase<0>(P, lds); xcd_barrier(xb);
    run_phase<1>(P, lds); xcd_barrier(xb);
    run_phase<2>(P, lds); xcd_barrier(xb);
    phase_tail(P, lds);
    if (P.ws == nullptr) grid.sync();
}
#else
template <int PH> __global__ __launch_bounds__(512, 2) void k_ph(Params P) {
    extern __shared__ __attribute__((aligned(16))) unsigned char shm[];
    run_phase<PH>(P, (LAS unsigned char*)shm);
}
#endif

extern "C" void kernel_launch(void* const* d_in, const int* in_sizes, int n_in, void* d_out, int out_size, void* d_ws, size_t ws_size, hipStream_t stream) {
    static int grid = 0;
    if (grid == 0) {
        if (n_in != 13 || out_size != NTOK * DM || ws_size < WS_END) { fprintf(stderr, "kernel_launch: unexpected shapes (n_in %d out %d ws %zu)\n", n_in, out_size, ws_size); grid = -1; return; }
        int dev = 0, cus = 0;
        (void)hipGetDevice(&dev);
        (void)hipDeviceGetAttribute(&cus, hipDeviceAttributeMultiprocessorCount, dev);
        bool ok = true;
#if N_LAUNCHES == 1
        ok = ok && hipFuncSetAttribute((const void*)fwd_kernel, hipFuncAttributeMaxDynamicSharedMemorySize, LDS_BYTES) == hipSuccess;
        int per_cu = 0;
        (void)hipOccupancyMaxActiveBlocksPerMultiprocessor(&per_cu, (const void*)fwd_kernel, 512, LDS_BYTES);
        if (per_cu < 1) fprintf(stderr, "kernel_launch: occupancy query says %d blocks per CU\n", per_cu);
#else
        ok = ok && hipFuncSetAttribute((const void*)k_ph<0>, hipFuncAttributeMaxDynamicSharedMemorySize, LDS_BYTES) == hipSuccess;
        ok = ok && hipFuncSetAttribute((const void*)k_ph<1>, hipFuncAttributeMaxDynamicSharedMemorySize, LDS_BYTES) == hipSuccess;
        ok = ok && hipFuncSetAttribute((const void*)k_ph<2>, hipFuncAttributeMaxDynamicSharedMemorySize, LDS_BYTES) == hipSuccess;
        ok = ok && hipFuncSetAttribute((const void*)k_ph<3>, hipFuncAttributeMaxDynamicSharedMemorySize, LDS_BYTES) == hipSuccess;
        ok = ok && hipFuncSetAttribute((const void*)k_ph<4>, hipFuncAttributeMaxDynamicSharedMemorySize, LDS_BYTES) == hipSuccess;
        ok = ok && hipFuncSetAttribute((const void*)k_ph<5>, hipFuncAttributeMaxDynamicSharedMemorySize, LDS_BYTES) == hipSuccess;
        ok = ok && hipFuncSetAttribute((const void*)k_ph<6>, hipFuncAttributeMaxDynamicSharedMemorySize, LDS_BYTES) == hipSuccess;
#endif
        (void)hipGetLastError();
        if (!ok) { fprintf(stderr, "kernel_launch: hipFuncSetAttribute failed\n"); grid = -1; return; }
        grid = 256;
        if (cus < 256) { fprintf(stderr, "kernel_launch: needs 256 CUs (one 256-row panel per workgroup), device has %d\n", cus); grid = -1; return; }
    }
    if (grid < 0) return;
    Params P{};
    P.x = (const float*)d_in[0]; P.p = (const float*)d_in[1]; P.ln_mix = (const float*)d_in[2]; P.w_in = (const float*)d_in[3]; P.rpb = (const float*)d_in[4];
    P.lb_logits = (const float*)d_in[5]; P.attn_norm = (const float*)d_in[6]; P.hgrn_norm = (const float*)d_in[7]; P.w_out = (const float*)d_in[8];
    P.ln_ple = (const float*)d_in[9]; P.w_pg = (const float*)d_in[10]; P.w_pp = (const float*)d_in[11]; P.ln_final = (const float*)d_in[12];
    P.out = (float*)d_out; P.ws = (unsigned char*)d_ws;
#if N_LAUNCHES == 1
    if (hipMemsetAsync((char*)d_ws + OFF_BAR, 0, XCD_BAR_WORDS * sizeof(unsigned), stream) != hipSuccess) { fprintf(stderr, "kernel_launch: hipMemsetAsync of the barrier words failed\n"); return; }
    void* args[] = {&P};
    hipError_t e = hipLaunchCooperativeKernel((const void*)fwd_kernel, dim3(grid), dim3(512), args, LDS_BYTES, stream);
    if (e != hipSuccess) fprintf(stderr, "cooperative launch failed: %s (grid %d)\n", hipGetErrorString(e), grid);
#else
    hipLaunchKernelGGL(k_ph<0>, dim3(grid), dim3(512), LDS_BYTES, stream, P);
    hipLaunchKernelGGL(k_ph<1>, dim3(grid), dim3(512), LDS_BYTES, stream, P);
    hipLaunchKernelGGL(k_ph<2>, dim3(grid), dim3(512), LDS_BYTES, stream, P);
    hipLaunchKernelGGL(k_ph<3>, dim3(grid), dim3(512), LDS_BYTES, stream, P);
    hipLaunchKernelGGL(k_ph<4>, dim3(grid), dim3(512), LDS_BYTES, stream, P);
    hipLaunchKernelGGL(k_ph<5>, dim3(grid), dim3(512), LDS_BYTES, stream, P);
    hipLaunchKernelGGL(k_ph<6>, dim3(grid), dim3(512), LDS_BYTES, stream, P);
#endif
}
```

```cpp
#include <hip/hip_runtime.h>
#include <hip/hip_cooperative_groups.h>
#include <cstdio>
namespace cg = cooperative_groups;

#ifndef N_LAUNCHES
#define N_LAUNCHES 1
#define PROBE_DUP -1
#endif

#define LAS __attribute__((address_space(3)))
typedef unsigned short bf16_t;
typedef short bf16x8 __attribute__((ext_vector_type(8)));
typedef float f32x2 __attribute__((ext_vector_type(2)));
typedef float f32x4 __attribute__((ext_vector_type(4)));
typedef float f32x16 __attribute__((ext_vector_type(16)));
typedef unsigned u32x2 __attribute__((ext_vector_type(2)));
typedef unsigned u32x4 __attribute__((ext_vector_type(4)));

constexpr int NTOK = 65536, DM = 1024, SEQ = 4096;
constexpr float EPS = 1e-6f;
constexpr size_t MiB = 1ull << 20;
constexpr size_t OFF_XB = 0, OFF_MIX = 0;
constexpr size_t OFF_Q = 128 * MiB, OFF_K = 192 * MiB, OFF_VT = 256 * MiB, OFF_SG = 320 * MiB, OFF_HQ = 384 * MiB;
constexpr size_t OFF_GF = 448 * MiB  , OFF_HIT = 576 * MiB, OFF_SHG = 640 * MiB;
constexpr size_t OFF_OD = 704 * MiB, OFF_HB = OFF_VT  , OFF_PB = 832 * MiB, OFF_PP = OFF_Q;
constexpr size_t OFF_HFB = OFF_GF  ;
constexpr size_t OFF_W1T = 864 * MiB, OFF_W2T = 873 * MiB, OFF_W3T = 875 * MiB, OFF_W4T = 877 * MiB;
constexpr size_t OFF_RSTD1 = 878 * MiB, OFF_SS2 = OFF_RSTD1 + 256 * 1024, OFF_SS3 = OFF_SS2 + 256 * 1024, OFF_LB = OFF_SS3 + 256 * 1024;
constexpr size_t OFF_BAR = 879 * MiB;
constexpr size_t WS_END = 880 * MiB;
constexpr int LDS_BYTES = 131072 + 2048 + 64;

struct Params {
    const float *x, *p, *ln_mix, *w_in, *rpb, *lb_logits, *attn_norm, *hgrn_norm, *w_out, *ln_ple, *w_pg, *w_pp, *ln_final;
    float* out;
    unsigned char* ws;
};

typedef __bf16 bf16x2v __attribute__((ext_vector_type(2)));
__device__ __forceinline__ unsigned pk2(float lo, float hi) { f32x2 v = {lo, hi}; bf16x2v b = __builtin_convertvector(v, bf16x2v); return __builtin_bit_cast(unsigned, b); }
__device__ __forceinline__ float bf_lo(unsigned u) { return __uint_as_float(u << 16); }
__device__ __forceinline__ float bf_hi(unsigned u) { return __uint_as_float(u & 0xffff0000u); }
__device__ __forceinline__ float bf1(bf16_t u) { return __uint_as_float(((unsigned)u) << 16); }
__device__ __forceinline__ float sigmoidf_(float v) { return __builtin_amdgcn_rcpf(1.0f + __expf(-v)); }
__device__ __forceinline__ float siluf_(float v) { return v * __builtin_amdgcn_rcpf(1.0f + __expf(-v)); }
__device__ __forceinline__ float wave_sum(float v) {
#pragma unroll
    for (int o = 1; o < 64; o <<= 1) v += __shfl_xor(v, o);
    return v;
}
#define LDS_BAR() do { asm volatile("s_waitcnt lgkmcnt(0)" ::: "memory"); __builtin_amdgcn_s_barrier(); asm volatile("" ::: "memory"); } while (0)

#define XB_TMO      128
#define XB_XCNT(j)  (256  + 64 * (j))
#define XB_XSUB(j)  (1280 + 64 * (j))
#define XB_XGEN(j)  (2304 + 64 * (j))
#define XB_TOP      3328
#define XB_TOPGEN   3392
#define XCD_BAR_WORDS 3456
#define XB_SPIN_CAP (1u << 20)
__device__ __forceinline__ unsigned xb_ld(unsigned* p)              { return __hip_atomic_load(p, __ATOMIC_RELAXED, __HIP_MEMORY_SCOPE_AGENT); }
__device__ __forceinline__ unsigned xb_add(unsigned* p, unsigned v) { return __hip_atomic_fetch_add(p, v, __ATOMIC_RELAXED, __HIP_MEMORY_SCOPE_AGENT); }
__device__ __forceinline__ unsigned xb_xcc_id() { return (unsigned)__builtin_amdgcn_s_getreg((3 << 11) | 20) & 0xFu; }
#define XB_SPIN(cond, bar) do { unsigned _sp = 0; while (cond) { __builtin_amdgcn_s_sleep(1); \
    if ((++_sp & 255u) == 0u) { if (xb_ld(&(bar)[XB_TMO])) break; if (_sp > XB_SPIN_CAP) { atomicAdd(&(bar)[XB_TMO], 1u); break; } } } } while (0)
struct XcdBarrier { unsigned* bar; unsigned x; volatile LAS unsigned* st; };
__device__ __forceinline__ XcdBarrier xcd_barrier_post(unsigned* bar, volatile LAS unsigned* st) {
    XcdBarrier b; b.bar = bar; b.x = xb_xcc_id(); b.st = st;
    if (threadIdx.x == 0) (void)xb_add(&bar[XB_XCNT(b.x)], 1u);
    return b;
}
__device__ __forceinline__ void xcd_barrier_complete(unsigned* bar, unsigned x, unsigned& nloc, unsigned& nx) {
    const unsigned G = gridDim.x * gridDim.y * gridDim.z;
    unsigned sum, cnt, mine, sp = 0u;
    for (;;) {
        sum = 0u; cnt = 0u; mine = 0u;
#pragma unroll
        for (unsigned j = 0; j < 16; ++j) { const unsigned c = xb_ld(&bar[XB_XCNT(j)]); sum += c; cnt += (c > 0u) ? 1u : 0u; mine = (j == x) ? c : mine; }
        if (sum == G) break;
        __builtin_amdgcn_s_sleep(1);
        if ((++sp & 255u) == 0u) { if (xb_ld(&bar[XB_TMO])) break; if (sp > XB_SPIN_CAP) { atomicAdd(&bar[XB_TMO], 1u); break; } }
    }
    nloc = mine > 0u ? mine : 1u; nx = cnt > 0u ? cnt : 1u;
}
__device__ __forceinline__ void xcd_barrier(const XcdBarrier& b) {
    asm volatile("s_waitcnt vmcnt(0)" ::: "memory");
    __syncthreads();
    if (threadIdx.x == 0) {
        unsigned* bar = b.bar;
        __builtin_amdgcn_s_waitcnt(0);
        unsigned nloc = b.st[0], nx = b.st[1];
        if (nloc == 0u) { xcd_barrier_complete(bar, b.x, nloc, nx); b.st[0] = nloc; b.st[1] = nx; }
        const unsigned old = xb_add(&bar[XB_XSUB(b.x)], 1u);
        const unsigned gen = old / nloc;
        if (old + 1u == (gen + 1u) * nloc) {
            __builtin_amdgcn_fence(__ATOMIC_RELEASE, "agent");
            asm volatile("s_waitcnt vmcnt(0)" ::: "memory");
            const unsigned og = xb_add(&bar[XB_TOP], 1u);
            const unsigned tg = og / nx;
            if (og + 1u == (tg + 1u) * nx) xb_add(&bar[XB_TOPGEN], 1u);
            else XB_SPIN(xb_ld(&bar[XB_TOPGEN]) == tg, bar);
            __builtin_amdgcn_fence(__ATOMIC_ACQUIRE, "agent");
            xb_add(&bar[XB_XGEN(b.x)], 1u);
            asm volatile("s_waitcnt vmcnt(0)" ::: "memory");
        } else {
            XB_SPIN(xb_ld(&bar[XB_XGEN(b.x)]) == gen, bar);
            __builtin_amdgcn_fence(__ATOMIC_ACQUIRE, "agent");
            asm volatile("s_waitcnt vmcnt(0)" ::: "memory");
        }
    }
    __syncthreads();
}

namespace pg8 {
constexpr int BM = 256, BK = 64, HALF = 128, HTB = HALF * BK * 2, STAGE_BYTES = 8 * HTB, NXCD = 8, WGM = 8;
__device__ __forceinline__ int lds_byte(int r, int c) { const int st = (r >> 4) * 2 + (c >> 5), rr = r & 15, cc = c & 31, ob = rr * 64 + cc * 2; return st * 1024 + (ob ^ (((ob >> 9) & 1) << 5)); }
__device__ __forceinline__ void stage_rc(int b, int& R, int& C) { const int st = b / 1024, sb = b % 1024, swz = sb ^ (((sb >> 9) & 1) << 5); R = (st >> 1) * 16 + swz / 64; C = (st & 1) * 32 + (swz % 64) / 2; }
__device__ __forceinline__ int perm32(int rho) { const int n = rho >> 4, i = rho & 15; return 8 * (i >> 2) + 4 * n + (i & 3); }
struct Unit { int pm, pn; };
struct Gemm { const bf16_t* A; const bf16_t* Bt; int M, N, K; };
struct StaticOrder {
    int nM, nN, nwg, G, c;
    __device__ void init(int M, int N, int G_, int c_) { nM = M / BM; nN = N / BM; nwg = nM * nN; G = G_; c = c_; }
    __device__ bool next(int i, Unit& u) const {
        const long L = (long)i * G + c; if (L >= nwg) return false;
        int wgid = (int)L; { const int q = nwg / NXCD, r = nwg % NXCD, xcd = wgid % NXCD, off = wgid / NXCD; wgid = (xcd < r ? xcd * (q + 1) : r * (q + 1) + (xcd - r) * q) + off; }
        const int nig = WGM * nN, gid = wgid / nig, fm = gid * WGM, gsz = (nM - fm) < WGM ? (nM - fm) : WGM;
        u.pm = fm + ((wgid % nig) % gsz); u.pn = (wgid % nig) / gsz; return true;
    }
};
template <class Epi, class Sched>
__device__ __forceinline__ void gemm_phase(LAS unsigned char* lds, const Gemm g, const Sched& S, const Epi& E) {
    int tid_ = threadIdx.x; asm volatile("" : "+v"(tid_));
    const int tid = tid_, wid = __builtin_amdgcn_readfirstlane(tid >> 6), lane = tid & 63, wr = wid >> 2, wc = wid & 3, fr = lane & 15, fq = lane >> 4;
    const int K = g.K, nt = K / BK;
    unsigned voffA[2], voffB[2];
#pragma unroll
    for (int i = 0; i < 2; ++i) { int R, C; stage_rc(tid * 16 + i * 8192, R, C); const int Rb = (R & ~31) + perm32(R & 31);
        voffA[i] = (unsigned)(R * K + C) * 2u; voffB[i] = (unsigned)(Rb * K + C) * 2u; }
    const size_t kstep = (size_t)(BK * 2);
    const size_t hstep = (size_t)HALF * K * 2;
    const size_t tstep = 2 * hstep;
    const unsigned ldsw = (unsigned)wid * 1024u;
    const int aoff = lds_byte(wr * 64 + fr, fq * 8), boff = lds_byte(wc * 32 + fr, fq * 8);
#define PG8_SA(b, h) (((b) * 2 + (h)) * HTB)
#define PG8_SB(b, h) ((4 + (b) * 2 + (h)) * HTB)
#define PG8_STAGE(bufoff, gbase, voff) do { _Pragma("unroll") for (int _i = 0; _i < 2; ++_i) \
        __builtin_amdgcn_global_load_lds((const unsigned*)((const char*)(gbase) + (voff)[_i]), (LAS unsigned*)(lds + (bufoff) + ldsw + _i * 8192), 16, 0, 0); } while (0)
#define PG8_LDA(dst, b, h) do { _Pragma("unroll") for (int m = 0; m < 4; ++m) _Pragma("unroll") for (int k = 0; k < 2; ++k) dst[m][k] = *(const LAS bf16x8*)(lds + PG8_SA(b, h) + aoff + m * 2048 + k * 1024); } while (0)
#define PG8_LDB(dst, b, h) do { _Pragma("unroll") for (int n = 0; n < 2; ++n) _Pragma("unroll") for (int k = 0; k < 2; ++k) dst[n][k] = *(const LAS bf16x8*)(lds + PG8_SB(b, h) + boff + n * 2048 + k * 1024); } while (0)
#define PG8_MMA(ai, bj, At, Bt) do { __builtin_amdgcn_s_setprio(1); _Pragma("unroll") for (int m = 0; m < 4; ++m) _Pragma("unroll") for (int n = 0; n < 2; ++n) _Pragma("unroll") for (int k = 0; k < 2; ++k) \
        acc[ai][bj][m][n] = __builtin_amdgcn_mfma_f32_16x16x32_bf16(Bt[n][k], At[m][k], acc[ai][bj][m][n], 0, 0, 0); __builtin_amdgcn_s_setprio(0); } while (0)
#define PG8_WAIT_V(n) asm volatile("s_waitcnt vmcnt(" #n ")" ::: "memory")
#define PG8_WAIT_L(n) asm volatile("s_waitcnt lgkmcnt(" #n ")" ::: "memory")
#define PG8_BAR __builtin_amdgcn_s_barrier()
#define PG8_SCHED __builtin_amdgcn_sched_barrier(0)
    Unit cur, nxt; int ui = 0;
    if (!S.next(0, cur)) return;
    f32x4 acc[2][2][4][2];
#pragma unroll
    for (int a = 0; a < 2; ++a)
#pragma unroll
        for (int b = 0; b < 2; ++b)
#pragma unroll
            for (int m = 0; m < 4; ++m)
#pragma unroll
                for (int n = 0; n < 2; ++n) acc[a][b][m][n] = (f32x4){0.f, 0.f, 0.f, 0.f};
    bf16x8 At[4][2], B0[2][2], B1[2][2];
    const char* cA = Epi::swapped(cur) ? (const char*)g.Bt + (size_t)cur.pn * tstep : (const char*)g.A + (size_t)cur.pm * tstep;
    const char* cB = Epi::swapped(cur) ? (const char*)g.A + (size_t)cur.pm * tstep : (const char*)g.Bt + (size_t)cur.pn * tstep;
    PG8_STAGE(PG8_SB(0, 0), cB, voffB); PG8_STAGE(PG8_SA(0, 0), cA, voffA); PG8_STAGE(PG8_SB(0, 1), cB + hstep, voffB); PG8_STAGE(PG8_SA(0, 1), cA + hstep, voffA);
    if (wr == 1) PG8_BAR;
    PG8_WAIT_V(4); PG8_BAR;
    PG8_STAGE(PG8_SB(1, 0), cB + kstep, voffB); PG8_STAGE(PG8_SA(1, 0), cA + kstep, voffA); PG8_STAGE(PG8_SB(1, 1), cB + hstep + kstep, voffB);
    PG8_WAIT_V(6); PG8_BAR;
    for (;;) {
        const bool has_next = S.next(ui + 1, nxt);
        const bool nsw = has_next && Epi::swapped(nxt);
        const char* nA = has_next ? (nsw ? (const char*)g.Bt + (size_t)nxt.pn * tstep : (const char*)g.A + (size_t)nxt.pm * tstep) : cA;
        const char* nB = has_next ? (nsw ? (const char*)g.A + (size_t)nxt.pm * tstep : (const char*)g.Bt + (size_t)nxt.pn * tstep) : cB;
        for (int t = 0; t < nt; t += 2) {
            const bool last = (t == nt - 2);
            const char* a1 = cA + (size_t)(t + 1) * kstep;
            const char* a2 = last ? nA : cA + (size_t)(t + 2) * kstep; const char* b2 = last ? nB : cB + (size_t)(t + 2) * kstep;
            const char* a3 = a2 + kstep; const char* b3 = b2 + kstep;
            PG8_LDB(B0, 0, 0); PG8_SCHED; PG8_LDA(At, 0, 0); PG8_STAGE(PG8_SA(1, 1), a1 + hstep, voffA);
            PG8_WAIT_L(8); PG8_BAR; PG8_WAIT_L(0); PG8_MMA(0, 0, At, B0); PG8_BAR; PG8_SCHED;
            PG8_LDB(B1, 0, 1); PG8_STAGE(PG8_SB(0, 0), b2, voffB);
            PG8_BAR; PG8_WAIT_L(0); PG8_MMA(0, 1, At, B1); PG8_BAR;
            PG8_LDA(At, 0, 1); PG8_STAGE(PG8_SA(0, 0), a2, voffA);
            PG8_BAR; PG8_WAIT_L(0); PG8_MMA(1, 0, At, B0); PG8_BAR; PG8_SCHED;
            PG8_STAGE(PG8_SB(0, 1), b2 + hstep, voffB);
            PG8_WAIT_V(6); PG8_BAR; PG8_MMA(1, 1, At, B1); PG8_BAR;
            PG8_LDB(B0, 1, 0); PG8_SCHED; PG8_LDA(At, 1, 0); PG8_STAGE(PG8_SA(0, 1), a2 + hstep, voffA);
            PG8_WAIT_L(8); PG8_BAR; PG8_WAIT_L(0); PG8_MMA(0, 0, At, B0); PG8_BAR; PG8_SCHED;
            PG8_LDB(B1, 1, 1); PG8_STAGE(PG8_SB(1, 0), b3, voffB);
            PG8_BAR; PG8_WAIT_L(0); PG8_MMA(0, 1, At, B1); PG8_BAR;
            PG8_LDA(At, 1, 1); PG8_STAGE(PG8_SA(1, 0), a3, voffA);
            PG8_BAR; PG8_WAIT_L(0); PG8_MMA(1, 0, At, B0); PG8_BAR; PG8_SCHED;
            PG8_STAGE(PG8_SB(1, 1), b3 + hstep, voffB);
            PG8_WAIT_V(6); PG8_BAR; PG8_MMA(1, 1, At, B1); PG8_BAR;
        }
        E(acc, cur, wr, wc, fr, fq);
        if (!has_next) break;
#pragma unroll
        for (int a = 0; a < 2; ++a)
#pragma unroll
            for (int b = 0; b < 2; ++b)
#pragma unroll
                for (int m = 0; m < 4; ++m)
#pragma unroll
                    for (int n = 0; n < 2; ++n) acc[a][b][m][n] = (f32x4){0.f, 0.f, 0.f, 0.f};
        cur = nxt; cA = nA; cB = nB; ++ui;
    }
    PG8_WAIT_V(0);
    if (wr == 0) PG8_BAR;
    PG8_BAR;
#undef PG8_SA
#undef PG8_SB
#undef PG8_STAGE
#undef PG8_LDA
#undef PG8_LDB
#undef PG8_MMA
#undef PG8_WAIT_V
#undef PG8_WAIT_L
#undef PG8_BAR
#undef PG8_SCHED
}
struct PanelOrder {
    int panel, nN;
    __device__ bool next(int i, Unit& u) const { if (i >= nN) return false; u.pm = panel; u.pn = i; return true; }
};
}
using pg8::Unit;
typedef f32x4 AccT[2][2][4][2];

struct Epi1 {
    unsigned char* ws;
    static __device__ __forceinline__ bool swapped(const Unit& u) { const int grp = u.pn >> 1; return grp == 2 || grp == 7; }
    template <int GRP> __device__ __forceinline__ void run(const AccT& acc, const Unit& u, int wr, int wc, int fr, int fq) const {
        if constexpr (GRP == 2 || GRP == 7) {
            const int t00 = u.pm * 256 + wc * 32 + 8 * fq;
            const int b = t00 >> 12;
#pragma unroll
            for (int ai = 0; ai < 2; ++ai)
#pragma unroll
                for (int m = 0; m < 4; ++m) {
                    const int col = (u.pn & 1) * 256 + ai * 128 + wr * 64 + m * 16 + fr;
#pragma unroll
                    for (int bj = 0; bj < 2; ++bj) {
                        const int s = (t00 + bj * 128) & 4095;
                        float v[8];
#pragma unroll
                        for (int e = 0; e < 4; ++e) { v[e] = acc[ai][bj][m][0][e]; v[4 + e] = acc[ai][bj][m][1][e]; }
                        u32x4 w; w.x = pk2(v[0], v[1]); w.y = pk2(v[2], v[3]); w.z = pk2(v[4], v[5]); w.w = pk2(v[6], v[7]);
                        if constexpr (GRP == 2)
                            *(u32x4*)((bf16_t*)(ws + OFF_VT) + ((size_t)((b * 8 + (col >> 6)) * 64 + (s >> 6)) * 64 + (col & 63)) * 64 + (s & 63)) = w;
                        else
                            *(u32x4*)((bf16_t*)(ws + OFF_HIT) + ((size_t)(b * 512 + col)) * 4096 + s) = w;
                    }
                }
            return;
        }
        const int colg0 = (u.pn & 1) * 256 + wc * 32 + 8 * fq;
        const int row0 = u.pm * 256 + wr * 64 + fr;
        float lbv[16];
        if constexpr (GRP == 5 || GRP == 6) {
            const float* lb = (const float*)(ws + OFF_LB) + (GRP - 5) * 512 + colg0;
#pragma unroll
            for (int bj = 0; bj < 2; ++bj) {
                const f32x4 a = *(const f32x4*)(lb + bj * 128), b = *(const f32x4*)(lb + bj * 128 + 4);
#pragma unroll
                for (int e = 0; e < 4; ++e) { lbv[bj * 8 + e] = a[e]; lbv[bj * 8 + 4 + e] = b[e]; }
            }
        }
#pragma unroll
        for (int ai = 0; ai < 2; ++ai)
#pragma unroll
            for (int m = 0; m < 4; ++m) {
                const int row = row0 + ai * 128 + m * 16;
                const int b = row >> 12, s = row & 4095;
#pragma unroll
                for (int bj = 0; bj < 2; ++bj) {
                    const int col = colg0 + bj * 128;
                    float v[8];
#pragma unroll
                    for (int e = 0; e < 4; ++e) { v[e] = acc[ai][bj][m][0][e]; v[4 + e] = acc[ai][bj][m][1][e]; }
                    if constexpr (GRP == 7) {
                        bf16_t* base = (bf16_t*)(ws + OFF_HIT) + ((size_t)(b * 512 + col)) * 4096 + s;
#pragma unroll
                        for (int e = 0; e < 8; ++e) base[(size_t)e * 4096] = (bf16_t)(pk2(v[e], 0.f) & 0xffffu);
                    } else if constexpr (GRP == 2) {
                        bf16_t* base = (bf16_t*)(ws + OFF_VT) + ((size_t)((b * 8 + (col >> 6)) * 64 + (s >> 6)) * 64 + (col & 63)) * 64 + (s & 63);
#pragma unroll
                        for (int e = 0; e < 8; ++e) base[e * 64] = (bf16_t)(pk2(v[e], 0.f) & 0xffffu);
                    } else if constexpr (GRP <= 1) {
                        if constexpr (GRP == 0) {
#pragma unroll
                            for (int e = 0; e < 8; ++e) v[e] *= 0.18033688011112042f;
                        }
                        u32x4 w; w.x = pk2(v[0], v[1]); w.y = pk2(v[2], v[3]); w.z = pk2(v[4], v[5]); w.w = pk2(v[6], v[7]);
                        *(u32x4*)((bf16_t*)(ws + (GRP == 0 ? OFF_Q : OFF_K)) + ((size_t)(b * 8 + (col >> 6)) * 4096 + s) * 64 + (col & 63)) = w;
                    } else {
                        if constexpr (GRP == 3 || GRP == 8) {
                        } else if constexpr (GRP == 4) {
#pragma unroll
                            for (int e = 0; e < 8; ++e) v[e] = siluf_(v[e]);
                        } else {
#pragma unroll
                            for (int e = 0; e < 8; ++e) { const float l = lbv[bj * 8 + e]; v[e] = __builtin_amdgcn_logf(l + (1.0f - l) * sigmoidf_(v[e]));   }
                        }
                        constexpr size_t off = GRP == 3 ? OFF_SG : GRP == 4 ? OFF_HQ : GRP == 5 ? OFF_GF : GRP == 6 ? OFF_GF + 64 * MiB : OFF_SHG;
                        u32x4 w; w.x = pk2(v[0], v[1]); w.y = pk2(v[2], v[3]); w.z = pk2(v[4], v[5]); w.w = pk2(v[6], v[7]);
                        *(u32x4*)((bf16_t*)(ws + off) + (size_t)row * 512 + col) = w;
                    }
                }
            }
    }
    __device__ __forceinline__ void operator()(const AccT& acc, const Unit& u, int wr, int wc, int fr, int fq) const {
        asm volatile("" : "+v"(fr), "+v"(fq));
        switch (u.pn >> 1) {
            case 0: run<0>(acc, u, wr, wc, fr, fq); break; case 1: run<1>(acc, u, wr, wc, fr, fq); break; case 2: run<2>(acc, u, wr, wc, fr, fq); break;
            case 3: run<3>(acc, u, wr, wc, fr, fq); break; case 4: run<4>(acc, u, wr, wc, fr, fq); break; case 5: run<5>(acc, u, wr, wc, fr, fq); break;
            case 6: run<6>(acc, u, wr, wc, fr, fq); break; case 7: run<7>(acc, u, wr, wc, fr, fq); break; default: run<8>(acc, u, wr, wc, fr, fq); break;
        }
    }
};
struct EpiPP {
    static __device__ __forceinline__ bool swapped(const Unit&) { return false; }
    bf16_t* O;
    __device__ __forceinline__ void operator()(const AccT& acc, const Unit& u, int wr, int wc, int fr, int fq) const {
        asm volatile("" : "+v"(fr), "+v"(fq));
        const int row0 = u.pm * 256 + wr * 64 + fr, col0 = u.pn * 256 + wc * 32 + 8 * fq;
#pragma unroll
        for (int ai = 0; ai < 2; ++ai)
#pragma unroll
            for (int m = 0; m < 4; ++m)
#pragma unroll
                for (int bj = 0; bj < 2; ++bj) {
                    const f32x4 v0 = acc[ai][bj][m][0], v1 = acc[ai][bj][m][1];
                    u32x4 w; w.x = pk2(v0[0], v0[1]); w.y = pk2(v0[2], v0[3]); w.z = pk2(v1[0], v1[1]); w.w = pk2(v1[2], v1[3]);
                    *(u32x4*)(O + (size_t)(row0 + ai * 128 + m * 16) * 1024 + col0 + bj * 128) = w;
                }
    }
};
struct Epi2 {
    static __device__ __forceinline__ bool swapped(const Unit&) { return false; }
    const float* x; float* out; bf16_t* hb; float* ss;
    __device__ __forceinline__ void operator()(const AccT& acc, const Unit& u, int wr, int wc, int fr, int fq) const {
        asm volatile("" : "+v"(fr), "+v"(fq));
        const int row0 = u.pm * 256 + wr * 64 + fr, col0 = u.pn * 256 + wc * 32 + 8 * fq;
#pragma unroll
        for (int ai = 0; ai < 2; ++ai) {
            f32x4 xv[4][2][2];
#pragma unroll
            for (int m = 0; m < 4; ++m)
#pragma unroll
                for (int bj = 0; bj < 2; ++bj) {
                    const size_t o = (size_t)(row0 + ai * 128 + m * 16) * 1024 + col0 + bj * 128;
                    xv[m][bj][0] = *(const f32x4*)(x + o); xv[m][bj][1] = *(const f32x4*)(x + o + 4);
                }
#pragma unroll
            for (int m = 0; m < 4; ++m) {
                const int row = row0 + ai * 128 + m * 16;
                float s2 = 0.f;
#pragma unroll
                for (int bj = 0; bj < 2; ++bj) {
                    const size_t o = (size_t)row * 1024 + col0 + bj * 128;
                    const f32x4 h0 = xv[m][bj][0] + acc[ai][bj][m][0], h1 = xv[m][bj][1] + acc[ai][bj][m][1];
                    *(f32x4*)(out + o) = h0; *(f32x4*)(out + o + 4) = h1;
                    u32x4 w; w.x = pk2(h0[0], h0[1]); w.y = pk2(h0[2], h0[3]); w.z = pk2(h1[0], h1[1]); w.w = pk2(h1[2], h1[3]);
                    *(u32x4*)(hb + o) = w;
                    s2 += h0[0] * h0[0] + h0[1] * h0[1] + h0[2] * h0[2] + h0[3] * h0[3] + h1[0] * h1[0] + h1[1] * h1[1] + h1[2] * h1[2] + h1[3] * h1[3];
                }
                s2 += __shfl_xor(s2, 16); s2 += __shfl_xor(s2, 32);
                if (fq == 0) atomicAdd(ss + row, s2);
            }
        }
    }
};
struct Epi3 {
    static __device__ __forceinline__ bool swapped(const Unit&) { return false; }
    float* out; const bf16_t* pp; const float* ss2; float* ss3;
    __device__ __forceinline__ void operator()(const AccT& acc, const Unit& u, int wr, int wc, int fr, int fq) const {
        asm volatile("" : "+v"(fr), "+v"(fq));
        const int row0 = u.pm * 256 + wr * 64 + fr, col0 = u.pn * 256 + wc * 32 + 8 * fq;
        float rsv[8];
#pragma unroll
        for (int i = 0; i < 8; ++i) rsv[i] = ss2[row0 + (i >> 2) * 128 + (i & 3) * 16];
#pragma unroll
        for (int ai = 0; ai < 2; ++ai)
#pragma unroll
            for (int mh = 0; mh < 2; ++mh) {
                f32x4 hv[2][2][2]; u32x4 pw[2][2];
#pragma unroll
                for (int mm = 0; mm < 2; ++mm)
#pragma unroll
                    for (int bj = 0; bj < 2; ++bj) {
                        const size_t o = (size_t)(row0 + ai * 128 + (mh * 2 + mm) * 16) * 1024 + col0 + bj * 128;
                        hv[mm][bj][0] = *(const f32x4*)(out + o); hv[mm][bj][1] = *(const f32x4*)(out + o + 4); pw[mm][bj] = *(const u32x4*)(pp + o);
                    }
#pragma unroll
                for (int mm = 0; mm < 2; ++mm) {
                    const int m = mh * 2 + mm, row = row0 + ai * 128 + m * 16;
                    const float rs = rsqrtf(rsv[ai * 4 + m] * (1.0f / 1024.0f) + EPS);
                    float s2 = 0.f;
#pragma unroll
                    for (int bj = 0; bj < 2; ++bj) {
                        const size_t o = (size_t)row * 1024 + col0 + bj * 128;
                        const u32x4 q = pw[mm][bj];
                        const float pv[8] = {bf_lo(q.x), bf_hi(q.x), bf_lo(q.y), bf_hi(q.y), bf_lo(q.z), bf_hi(q.z), bf_lo(q.w), bf_hi(q.w)};
                        f32x4 r0, r1;
#pragma unroll
                        for (int e = 0; e < 4; ++e) {
                            r0[e] = hv[mm][bj][0][e] + sigmoidf_(acc[ai][bj][m][0][e] * rs) * pv[e];
                            r1[e] = hv[mm][bj][1][e] + sigmoidf_(acc[ai][bj][m][1][e] * rs) * pv[4 + e];
                            s2 += r0[e] * r0[e] + r1[e] * r1[e];
                        }
                        *(f32x4*)(out + o) = r0; *(f32x4*)(out + o + 4) = r1;
                    }
                    s2 += __shfl_xor(s2, 16); s2 += __shfl_xor(s2, 32);
                    if (fq == 0) atomicAdd(ss3 + row, s2);
                }
            }
    }
};

struct Epi2P {
    static __device__ __forceinline__ bool swapped(const Unit&) { return false; }
    const float* x; float* out; bf16_t* hb; LAS float* ssl;
    __device__ __forceinline__ void operator()(const AccT& acc, const Unit& u, int wr, int wc, int fr, int fq) const {
        asm volatile("" : "+v"(fr), "+v"(fq));
        const int lrow0 = wr * 64 + fr, row0 = u.pm * 256 + lrow0, col0 = u.pn * 256 + wc * 32 + 8 * fq;
#pragma unroll
        for (int ai = 0; ai < 2; ++ai) {
            f32x4 xv[4][2][2];
#pragma unroll
            for (int m = 0; m < 4; ++m)
#pragma unroll
                for (int bj = 0; bj < 2; ++bj) {
                    const size_t o = (size_t)(row0 + ai * 128 + m * 16) * 1024 + col0 + bj * 128;
                    xv[m][bj][0] = *(const f32x4*)(x + o); xv[m][bj][1] = *(const f32x4*)(x + o + 4);
                }
#pragma unroll
            for (int m = 0; m < 4; ++m) {
                const int row = row0 + ai * 128 + m * 16;
                float s2 = 0.f;
#pragma unroll
                for (int bj = 0; bj < 2; ++bj) {
                    const size_t o = (size_t)row * 1024 + col0 + bj * 128;
                    const f32x4 h0 = xv[m][bj][0] + acc[ai][bj][m][0], h1 = xv[m][bj][1] + acc[ai][bj][m][1];
                    u32x4 w; w.x = pk2(h0[0], h0[1]); w.y = pk2(h0[2], h0[3]); w.z = pk2(h1[0], h1[1]); w.w = pk2(h1[2], h1[3]);
                    *(u32x4*)(hb + o) = w;
                    s2 += h0[0] * h0[0] + h0[1] * h0[1] + h0[2] * h0[2] + h0[3] * h0[3] + h1[0] * h1[0] + h1[1] * h1[1] + h1[2] * h1[2] + h1[3] * h1[3];
                }
                s2 += __shfl_xor(s2, 16); s2 += __shfl_xor(s2, 32);
                if (fq == 0) __hip_atomic_fetch_add(ssl + lrow0 + ai * 128 + m * 16, s2, __ATOMIC_RELAXED, __HIP_MEMORY_SCOPE_WORKGROUP);
            }
        }
    }
};
struct Epi3P {
    static __device__ __forceinline__ bool swapped(const Unit&) { return false; }
    bf16_t* hfb; const bf16_t* pp; const bf16_t* hb; const LAS float* ss2l; LAS float* ss3l;
    __device__ __forceinline__ void operator()(const AccT& acc, const Unit& u, int wr, int wc, int fr, int fq) const {
        asm volatile("" : "+v"(fr), "+v"(fq));
        const int lrow0 = wr * 64 + fr, row0 = u.pm * 256 + lrow0, col0 = u.pn * 256 + wc * 32 + 8 * fq;
#pragma unroll
        for (int ai = 0; ai < 2; ++ai) {
            u32x4 hw[4][2], pw[4][2];
#pragma unroll
            for (int m = 0; m < 4; ++m)
#pragma unroll
                for (int bj = 0; bj < 2; ++bj) {
                    const size_t o = (size_t)(row0 + ai * 128 + m * 16) * 1024 + col0 + bj * 128;
                    hw[m][bj] = *(const u32x4*)(hb + o); pw[m][bj] = *(const u32x4*)(pp + o);
                }
#pragma unroll
            for (int m = 0; m < 4; ++m) {
                const int lrow = lrow0 + ai * 128 + m * 16, row = u.pm * 256 + lrow;
                const float rs = rsqrtf(ss2l[lrow] * (1.0f / 1024.0f) + EPS);
                float s2 = 0.f;
#pragma unroll
                for (int bj = 0; bj < 2; ++bj) {
                    const size_t o = (size_t)row * 1024 + col0 + bj * 128;
                    const u32x4 q = pw[m][bj], hq = hw[m][bj];
                    const float pv[8] = {bf_lo(q.x), bf_hi(q.x), bf_lo(q.y), bf_hi(q.y), bf_lo(q.z), bf_hi(q.z), bf_lo(q.w), bf_hi(q.w)};
                    const float hv[8] = {bf_lo(hq.x), bf_hi(hq.x), bf_lo(hq.y), bf_hi(hq.y), bf_lo(hq.z), bf_hi(hq.z), bf_lo(hq.w), bf_hi(hq.w)};
                    f32x4 r0, r1;
#pragma unroll
                    for (int e = 0; e < 4; ++e) {
                        r0[e] = hv[e] + sigmoidf_(acc[ai][bj][m][0][e] * rs) * pv[e];
                        r1[e] = hv[4 + e] + sigmoidf_(acc[ai][bj][m][1][e] * rs) * pv[4 + e];
                        s2 += r0[e] * r0[e] + r1[e] * r1[e];
                    }
                    u32x4 w; w.x = pk2(r0[0], r0[1]); w.y = pk2(r0[2], r0[3]); w.z = pk2(r1[0], r1[1]); w.w = pk2(r1[2], r1[3]);
                    *(u32x4*)(hfb + o) = w;
                }
                s2 += __shfl_xor(s2, 16); s2 += __shfl_xor(s2, 32);
                if (fq == 0) __hip_atomic_fetch_add(ss3l + lrow, s2, __ATOMIC_RELAXED, __HIP_MEMORY_SCOPE_WORKGROUP);
            }
        }
    }
};

__device__ __forceinline__ void transpose_w(const float* W, const float* scale, bf16_t* WT, int K, int N, int gt, int NT) {
    const int total = N * (K / 8);
    for (int idx = gt; idx < total; idx += NT) {
        const int n = idx % N, k0 = (idx / N) * 8;
        float v[8];
#pragma unroll
        for (int j = 0; j < 8; ++j) { v[j] = W[(size_t)(k0 + j) * N + n]; if (scale) v[j] *= scale[k0 + j]; }
        u32x4 w; w.x = pk2(v[0], v[1]); w.y = pk2(v[2], v[3]); w.z = pk2(v[4], v[5]); w.w = pk2(v[6], v[7]);
        *(u32x4*)(WT + (size_t)n * K + k0) = w;
    }
}
__device__ __forceinline__ void phase_prep(const Params& P) {
    const int tid = threadIdx.x, wave = tid >> 6, lane = tid & 63;
    const int gw = blockIdx.x * 8 + wave, NGW = gridDim.x * 8;
    const int gt = blockIdx.x * 512 + tid, NT = gridDim.x * 512;
    unsigned char* ws = P.ws;
    bf16_t* xb = (bf16_t*)(ws + OFF_XB);
    float* rstd1 = (float*)(ws + OFF_RSTD1);
    for (int row = gw; row < NTOK; row += 2 * NGW) {
        const int row2 = row + NGW;
        const f32x4* xr = (const f32x4*)(P.x + (size_t)row * 1024) + lane;
        const f32x4* xr2 = (const f32x4*)(P.x + (size_t)row2 * 1024) + lane;
        f32x4 v[4], v2[4]; float s = 0.f, s2 = 0.f;
#pragma unroll
        for (int j = 0; j < 4; ++j) { v[j] = xr[64 * j]; v2[j] = xr2[64 * j]; }
#pragma unroll
        for (int j = 0; j < 4; ++j) { s += v[j][0] * v[j][0] + v[j][1] * v[j][1] + v[j][2] * v[j][2] + v[j][3] * v[j][3];
                                      s2 += v2[j][0] * v2[j][0] + v2[j][1] * v2[j][1] + v2[j][2] * v2[j][2] + v2[j][3] * v2[j][3]; }
        s = wave_sum(s); s2 = wave_sum(s2);
        const float rs = rsqrtf(s * (1.0f / 1024.0f) + EPS), rs2 = rsqrtf(s2 * (1.0f / 1024.0f) + EPS);
        u32x2* o = (u32x2*)(xb + (size_t)row * 1024) + lane;
        u32x2* o2 = (u32x2*)(xb + (size_t)row2 * 1024) + lane;
#pragma unroll
        for (int j = 0; j < 4; ++j) { u32x2 w; w.x = pk2(v[j][0] * rs, v[j][1] * rs); w.y = pk2(v[j][2] * rs, v[j][3] * rs); o[64 * j] = w;
                                      u32x2 w2; w2.x = pk2(v2[j][0] * rs2, v2[j][1] * rs2); w2.y = pk2(v2[j][2] * rs2, v2[j][3] * rs2); o2[64 * j] = w2; }
    }
    transpose_w(P.w_in, P.ln_mix, (bf16_t*)(ws + OFF_W1T), 1024, 4608, gt, NT);
    transpose_w(P.w_out, nullptr, (bf16_t*)(ws + OFF_W2T), 1024, 1024, gt, NT);
    transpose_w(P.w_pg, P.ln_ple, (bf16_t*)(ws + OFF_W3T), 1024, 1024, gt, NT);
    transpose_w(P.w_pp, nullptr, (bf16_t*)(ws + OFF_W4T), 256, 1024, gt, NT);
    float* lb = (float*)(ws + OFF_LB);
    for (int i = gt; i < 1024; i += NT) lb[i] = sigmoidf_(P.lb_logits[i] - P.lb_logits[1024 + i]);
    float* ss2 = (float*)(ws + OFF_SS2); float* ss3 = (float*)(ws + OFF_SS3);
    for (int i = gt; i < NTOK; i += NT) { ss2[i] = 0.f; ss3[i] = 0.f; }
}

constexpr int HS_LD = 136, HS_LD64 = 72;
constexpr int L_QT = 0, L_QH = 17408, L_KH = 34816, L_KT = 52224, L_VTT = 70656, L_P = 79872, L_ST = 89088, L_SEG = 106496, L_ETOT = 110592;
#define MFMA32(a, b, c) __builtin_amdgcn_mfma_f32_32x32x16_bf16((a), (b), (c), 0, 0, 0)
#define MFMA16(a, b, c) __builtin_amdgcn_mfma_f32_16x16x32_bf16((a), (b), (c), 0, 0, 0)

__device__ __forceinline__ void hgrn_scan_task(const Params& P, LAS unsigned char* lds, int task) {
    const int tid = threadIdx.x, w = __builtin_amdgcn_readfirstlane(tid >> 6), lane = tid & 63;
    const int half = task & 1, h = (task >> 1) & 3, b = (task >> 3) & 15, dir = task >> 7;
    LAS unsigned* QT32 = (LAS unsigned*)(lds + L_QT); LAS unsigned* QH32 = (LAS unsigned*)(lds + L_QH); LAS unsigned* KH32 = (LAS unsigned*)(lds + L_KH);
    LAS bf16_t* QT = (LAS bf16_t*)(lds + L_QT); LAS bf16_t* QH = (LAS bf16_t*)(lds + L_QH); LAS bf16_t* KH = (LAS bf16_t*)(lds + L_KH);
    LAS bf16_t* KT = (LAS bf16_t*)(lds + L_KT); LAS bf16_t* VTT = (LAS bf16_t*)(lds + L_VTT); LAS bf16_t* PL = (LAS bf16_t*)(lds + L_P);
    LAS bf16_t* ST = (LAS bf16_t*)(lds + L_ST); LAS float* SEG = (LAS float*)(lds + L_SEG); LAS float* ETOT = (LAS float*)(lds + L_ETOT);
    const bf16_t* G = (const bf16_t*)(P.ws + OFF_GF + (size_t)dir * 64 * MiB);
    const bf16_t* HQ = (const bf16_t*)(P.ws + OFF_HQ);
    const bf16_t* HIT = (const bf16_t*)(P.ws + OFF_HIT);
    bf16_t* OD = (bf16_t*)(P.ws + OFF_OD + (size_t)dir * 64 * MiB);
    for (int i = tid; i < 64 * HS_LD / 2; i += 512) ((LAS unsigned*)ST)[i] = 0u;
    f32x16 sacc;
#pragma unroll
    for (int i = 0; i < 16; ++i) sacc[i] = 0.f;
    const size_t tokbase = (size_t)b * 4096;
    const int r = lane & 31, hh = lane >> 5;
    const char* g_u = (const char*)G + (tokbase + 8 * w) * 1024 + h * 256;
    const char* q_u = (const char*)HQ + (tokbase + 8 * w) * 1024 + h * 256;
    const char* v_u = (const char*)HIT + ((size_t)((b * 4 + h) * 128 + half * 64)) * 8192;
    const unsigned gq_off = 4u * lane, v_off = (unsigned)(tid >> 3) * 8192u + (unsigned)(tid & 7) * 16u;
    unsigned gr[8], qr[8]; u32x4 vr;
#define HS_LOAD(c) do { const char* gc_ = g_u + (size_t)(c) * 65536; const char* qc_ = q_u + (size_t)(c) * 65536; \
        _Pragma("unroll") for (int i = 0; i < 8; ++i) { gr[i] = *(const unsigned*)(gc_ + i * 1024 + gq_off); qr[i] = *(const unsigned*)(qc_ + i * 1024 + gq_off); } \
        vr = *(const u32x4*)(v_u + (size_t)(c) * 128 + v_off); } while (0)
    { const int c0 = dir ? 63 : 0; HS_LOAD(c0); }
    for (int ci = 0; ci < 64; ++ci) {
        const int c = dir ? 63 - ci : ci;
        float g0[8], g1[8], bl0[8], bl1[8];
#pragma unroll
        for (int i = 0; i < 8; ++i) { g0[i] = bf_lo(gr[i]); g1[i] = bf_hi(gr[i]); }
        float a0 = 0.f, a1 = 0.f;
        if (dir == 0) {
#pragma unroll
            for (int i = 0; i < 8; ++i) { a0 += g0[i]; a1 += g1[i]; bl0[i] = a0; bl1[i] = a1; }
        } else {
#pragma unroll
            for (int i = 7; i >= 0; --i) { a0 += g0[i]; a1 += g1[i]; bl0[i] = a0; bl1[i] = a1; }
        }
        *(LAS f32x2*)(SEG + w * 128 + 2 * lane) = (f32x2){a0, a1};
        LDS_BAR();
        float off0 = 0.f, off1 = 0.f, ref0 = 0.f, ref1 = 0.f, tot0 = 0.f, tot1 = 0.f;
#pragma unroll
        for (int w2 = 0; w2 < 8; ++w2) {
            const f32x2 sv = *(const LAS f32x2*)(SEG + w2 * 128 + 2 * lane);
            tot0 += sv[0]; tot1 += sv[1];
            const bool before = dir == 0 ? (w2 < w) : (w2 > w);
            const bool inref = dir == 0 ? (w2 < 4) : (w2 >= 4);
            if (before) { off0 += sv[0]; off1 += sv[1]; }
            if (inref) { ref0 += sv[0]; ref1 += sv[1]; }
        }
        float kta[8], ktb[8];
        const float er0 = __builtin_amdgcn_exp2f(ref0), er1 = __builtin_amdgcn_exp2f(ref1), et0 = __builtin_amdgcn_exp2f(tot0 - ref0), et1 = __builtin_amdgcn_exp2f(tot1 - ref1);
#pragma unroll
        for (int i = 0; i < 8; ++i) {
            const int t = 8 * w + i;
            const float b0 = off0 + bl0[i], b1 = off1 + bl1[i];
            const float q0 = bf_lo(qr[i]), q1 = bf_hi(qr[i]);
            const float k0 = 1.0f - __builtin_amdgcn_exp2f(g0[i]), k1 = 1.0f - __builtin_amdgcn_exp2f(g1[i]);
            const float qh0 = q0 * __builtin_amdgcn_exp2f(fminf(b0 - ref0, 115.f)), qh1 = q1 * __builtin_amdgcn_exp2f(fminf(b1 - ref1, 115.f));
            const float kh0 = k0 * __builtin_amdgcn_exp2f(fminf(ref0 - b0, 115.f)), kh1 = k1 * __builtin_amdgcn_exp2f(fminf(ref1 - b1, 115.f));
            QT32[t * (HS_LD / 2) + lane] = pk2(qh0 * er0, qh1 * er1);
            QH32[t * (HS_LD / 2) + lane] = pk2(qh0, qh1);
            KH32[t * (HS_LD / 2) + lane] = pk2(kh0, kh1);
            kta[i] = kh0 * et0; ktb[i] = kh1 * et1;
        }
        { u32x4 wa, wb; wa.x = pk2(kta[0], kta[1]); wa.y = pk2(kta[2], kta[3]); wa.z = pk2(kta[4], kta[5]); wa.w = pk2(kta[6], kta[7]);
          wb.x = pk2(ktb[0], ktb[1]); wb.y = pk2(ktb[2], ktb[3]); wb.z = pk2(ktb[4], ktb[5]); wb.w = pk2(ktb[6], ktb[7]);
          *(LAS u32x4*)(KT + (2 * lane) * HS_LD64 + 8 * w) = wa; *(LAS u32x4*)(KT + (2 * lane + 1) * HS_LD64 + 8 * w) = wb; }
        *(LAS u32x4*)(VTT + (tid >> 3) * HS_LD64 + (tid & 7) * 8) = vr;
        if (w == 0) { *(LAS f32x2*)(ETOT + 2 * lane) = (f32x2){__builtin_amdgcn_exp2f(tot0), __builtin_amdgcn_exp2f(tot1)}; }
        LDS_BAR();
        if (ci + 1 < 64) { const int cn = dir ? 62 - ci : ci + 1; HS_LOAD(cn); }
        f32x16 o;
#pragma unroll
        for (int i = 0; i < 16; ++i) o[i] = 0.f;
        const int ti = (w >> 1) & 1, di = w & 1;
        if (w < 4) {
            const int si = w >> 1, tj = w & 1;
            f32x16 sc;
#pragma unroll
            for (int i = 0; i < 16; ++i) sc[i] = 0.f;
#pragma unroll
            for (int ks = 0; ks < 8; ++ks) {
                const bf16x8 a = *(const LAS bf16x8*)(KH + (32 * si + r) * HS_LD + 16 * ks + 8 * hh);
                const bf16x8 bq = *(const LAS bf16x8*)(QH + (32 * tj + r) * HS_LD + 16 * ks + 8 * hh);
                sc = MFMA32(a, bq, sc);
            }
            const int t = 32 * tj + r;
#pragma unroll
            for (int q4 = 0; q4 < 4; ++q4) {
                const int s0 = 32 * si + 8 * q4 + 4 * hh;
                float pv[4];
#pragma unroll
                for (int e = 0; e < 4; ++e) { const int s = s0 + e; const bool keep = dir == 0 ? (s <= t) : (s >= t); pv[e] = keep ? sc[4 * q4 + e] : 0.f; }
                u32x2 wv; wv.x = pk2(pv[0], pv[1]); wv.y = pk2(pv[2], pv[3]);
                *(LAS u32x2*)(PL + t * HS_LD64 + s0) = wv;
            }
        } else {
#pragma unroll
            for (int ks = 0; ks < 8; ++ks) {
                const bf16x8 a = *(const LAS bf16x8*)(QT + (32 * ti + r) * HS_LD + 16 * ks + 8 * hh);
                const bf16x8 bs = *(const LAS bf16x8*)(ST + (32 * di + r) * HS_LD + 16 * ks + 8 * hh);
                o = MFMA32(a, bs, o);
            }
        }
        LDS_BAR();
        if (w >= 4) {
#pragma unroll
            for (int ks = 0; ks < 4; ++ks) {
                const bf16x8 a = *(const LAS bf16x8*)(PL + (32 * ti + r) * HS_LD64 + 16 * ks + 8 * hh);
                const bf16x8 bv = *(const LAS bf16x8*)(VTT + (32 * di + r) * HS_LD64 + 16 * ks + 8 * hh);
                o = MFMA32(a, bv, o);
            }
            char* o_u = (char*)OD + (tokbase + 64 * c + 32 * ti) * 1024 + (h * 128 + half * 64 + 32 * di) * 2;
            const unsigned o_off = (unsigned)hh * 4096u + 2u * (unsigned)r;
#pragma unroll
            for (int i = 0; i < 16; ++i) { const int tr = (i & 3) + 8 * (i >> 2); *(bf16_t*)(o_u + tr * 1024 + o_off) = (bf16_t)(pk2(o[i], 0.f) & 0xffffu); }
        }
        {
            const int ki = w >> 1, dj = w & 1;
#pragma unroll
            for (int q4 = 0; q4 < 4; ++q4) {
                const f32x4 et = *(const LAS f32x4*)(ETOT + 32 * ki + 8 * q4 + 4 * hh);
#pragma unroll
                for (int e = 0; e < 4; ++e) sacc[4 * q4 + e] *= et[e];
            }
#pragma unroll
            for (int ks = 0; ks < 4; ++ks) {
                const bf16x8 a = *(const LAS bf16x8*)(KT + (32 * ki + r) * HS_LD64 + 16 * ks + 8 * hh);
                const bf16x8 bv = *(const LAS bf16x8*)(VTT + (32 * dj + r) * HS_LD64 + 16 * ks + 8 * hh);
                sacc = MFMA32(a, bv, sacc);
            }
#pragma unroll
            for (int q4 = 0; q4 < 4; ++q4) {
                u32x2 wv; wv.x = pk2(sacc[4 * q4], sacc[4 * q4 + 1]); wv.y = pk2(sacc[4 * q4 + 2], sacc[4 * q4 + 3]);
                *(LAS u32x2*)(ST + (32 * dj + r) * HS_LD + 32 * ki + 8 * q4 + 4 * hh) = wv;
            }
        }
    }
    LDS_BAR();
#undef HS_LOAD
}

constexpr int S2_LD = 136, S2_LDC = 40;
constexpr int S2_BUF = 41984, S2_QT = 0, S2_QH = 8704, S2_KH = 17408, S2_KT = 26112, S2_VT = 36352;
constexpr int S2_ETOT = 83968, S2_P = 84992, S2_ST = 87552, S2_SEG = 104960;
template <int DIR>
__device__ __forceinline__ void hgrn_scan2(const Params& P, LAS unsigned char* lds, int task) {
    const int tid = threadIdx.x, w = __builtin_amdgcn_readfirstlane(tid >> 6), lane = tid & 63;
    const int half = task & 1, h = (task >> 1) & 3, b = (task >> 3) & 15;
    const bf16_t* G = (const bf16_t*)(P.ws + OFF_GF + (size_t)DIR * 64 * MiB);
    const bf16_t* HQ = (const bf16_t*)(P.ws + OFF_HQ);
    const bf16_t* HIT = (const bf16_t*)(P.ws + OFF_HIT);
    bf16_t* OD = (bf16_t*)(P.ws + OFF_OD + (size_t)DIR * 64 * MiB);
    const size_t tokbase = (size_t)b * 4096;
    LAS bf16_t* ST = (LAS bf16_t*)(lds + S2_ST); LAS bf16_t* PL = (LAS bf16_t*)(lds + S2_P);
    LAS float* SEG = (LAS float*)(lds + S2_SEG);
    for (int i = tid; i < 64 * S2_LD / 2; i += 512) ((LAS unsigned*)ST)[i] = 0u;
    const int r = lane & 31, hh = lane >> 5;
    if (w < 4) {
        const char* g_u = (const char*)G + (tokbase + 8 * w) * 1024 + h * 256;
        const char* q_u = (const char*)HQ + (tokbase + 8 * w) * 1024 + h * 256;
        const char* v_u = (const char*)HIT + ((size_t)((b * 4 + h) * 128 + half * 64)) * 8192;
        const unsigned gq_off = 4u * lane, v_off = (unsigned)(tid >> 2) * 8192u + (unsigned)(tid & 3) * 16u;
        unsigned gA[8], qA[8], gB[8], qB[8]; u32x4 vA, vB;
#define S2_LOAD(gr, qr, vr, s_) do { const int c_ = DIR ? 127 - (s_) : (s_); const char* gc_ = g_u + (size_t)c_ * 32768; const char* qc_ = q_u + (size_t)c_ * 32768; \
        _Pragma("unroll") for (int i = 0; i < 8; ++i) { gr[i] = *(const unsigned*)(gc_ + i * 1024 + gq_off); qr[i] = *(const unsigned*)(qc_ + i * 1024 + gq_off); } \
        vr = *(const u32x4*)(v_u + (size_t)c_ * 64 + v_off); } while (0)
#define S2_PRODUCE(gr, qr, vr, s_) do { \
          \
        LAS unsigned char* bufp = lds + ((s_) & 1) * S2_BUF; \
        *(LAS u32x4*)((LAS bf16_t*)(bufp + S2_VT) + (tid >> 2) * S2_LDC + (tid & 3) * 8) = vr; \
        float qe0[8], qe1[8], ke0[8], ke1[8]; \
        float a0 = 0.f, a1 = 0.f, p0 = 1.f, p1 = 1.f; \
        _Pragma("unroll") for (int ii = 0; ii < 8; ++ii) { \
            const int i = DIR == 0 ? ii : 7 - ii; \
            const float gg0 = bf_lo(gr[i]), gg1 = bf_hi(gr[i]), q0 = bf_lo(qr[i]), q1 = bf_hi(qr[i]); \
            a0 += gg0; a1 += gg1; \
            const float f0 = __builtin_amdgcn_exp2f(gg0), f1 = __builtin_amdgcn_exp2f(gg1); \
            p0 *= f0; p1 *= f1; \
            qe0[i] = q0 * p0; qe1[i] = q1 * p1; \
            ke0[i] = (1.0f - f0) * __builtin_amdgcn_exp2f(-a0); ke1[i] = (1.0f - f1) * __builtin_amdgcn_exp2f(-a1); } \
        if ((s_) + 2 < 128) S2_LOAD(gr, qr, vr, (s_) + 2); \
        *(LAS f32x2*)(SEG + w * 128 + 2 * lane) = (f32x2){a0, a1}; \
        LDS_BAR(); \
        float off0 = 0.f, off1 = 0.f, ref0 = 0.f, ref1 = 0.f, tot0 = 0.f, tot1 = 0.f; \
        _Pragma("unroll") for (int w2 = 0; w2 < 4; ++w2) { \
            const f32x2 sv = *(const LAS f32x2*)(SEG + w2 * 128 + 2 * lane); \
            tot0 += sv[0]; tot1 += sv[1]; \
            if (DIR == 0 ? (w2 < w) : (w2 > w)) { off0 += sv[0]; off1 += sv[1]; } \
            if (DIR == 0 ? (w2 < 2) : (w2 >= 2)) { ref0 += sv[0]; ref1 += sv[1]; } } \
        const float A0 = __builtin_amdgcn_exp2f(off0 - ref0), A1 = __builtin_amdgcn_exp2f(off1 - ref1); \
        const float B0 = __builtin_amdgcn_exp2f(ref0 - off0), B1 = __builtin_amdgcn_exp2f(ref1 - off1); \
        const float AQ0 = __builtin_amdgcn_exp2f(off0), AQ1 = __builtin_amdgcn_exp2f(off1); \
        const float BK0 = __builtin_amdgcn_exp2f(tot0 - off0), BK1 = __builtin_amdgcn_exp2f(tot1 - off1); \
        _Pragma("unroll") for (int i = 0; i < 8; ++i) { \
            const int t = 8 * w + i; \
            ((LAS unsigned*)(bufp + S2_QT))[t * (S2_LD / 2) + lane] = pk2(qe0[i] * AQ0, qe1[i] * AQ1); \
            ((LAS unsigned*)(bufp + S2_QH))[t * (S2_LD / 2) + lane] = pk2(qe0[i] * A0, qe1[i] * A1); \
            ((LAS unsigned*)(bufp + S2_KH))[t * (S2_LD / 2) + lane] = pk2(ke0[i] * B0, ke1[i] * B1); } \
        { u32x4 wa, wb; wa.x = pk2(ke0[0] * BK0, ke0[1] * BK0); wa.y = pk2(ke0[2] * BK0, ke0[3] * BK0); wa.z = pk2(ke0[4] * BK0, ke0[5] * BK0); wa.w = pk2(ke0[6] * BK0, ke0[7] * BK0); \
          wb.x = pk2(ke1[0] * BK1, ke1[1] * BK1); wb.y = pk2(ke1[2] * BK1, ke1[3] * BK1); wb.z = pk2(ke1[4] * BK1, ke1[5] * BK1); wb.w = pk2(ke1[6] * BK1, ke1[7] * BK1); \
          *(LAS u32x4*)((LAS bf16_t*)(bufp + S2_KT) + (2 * lane) * S2_LDC + 8 * w) = wa; *(LAS u32x4*)((LAS bf16_t*)(bufp + S2_KT) + (2 * lane + 1) * S2_LDC + 8 * w) = wb; } \
        if (w == 0) *(LAS f32x2*)((LAS float*)(lds + S2_ETOT) + ((s_) & 1) * 128 + 2 * lane) = (f32x2){__builtin_amdgcn_exp2f(tot0), __builtin_amdgcn_exp2f(tot1)}; \
        LDS_BAR(); } while (0)
        S2_LOAD(gA, qA, vA, 0); S2_LOAD(gB, qB, vB, 1);
        for (int s = 0; s < 128; s += 2) { S2_PRODUCE(gA, qA, vA, s); S2_PRODUCE(gB, qB, vB, s + 1); }
        LDS_BAR(); LDS_BAR();
#undef S2_LOAD
#undef S2_PRODUCE
    } else {
        const int wb = w - 4;
        f32x16 sacc0, sacc1;
#pragma unroll
        for (int i = 0; i < 16; ++i) { sacc0[i] = 0.f; sacc1[i] = 0.f; }
        LDS_BAR(); LDS_BAR();
        for (int s = 1; s <= 128; ++s) {
            const int cs = s - 1, c = DIR ? 127 - cs : cs;
            const LAS unsigned char* bufp = lds + (cs & 1) * S2_BUF;
            const LAS bf16_t* QT = (const LAS bf16_t*)(bufp + S2_QT); const LAS bf16_t* QH = (const LAS bf16_t*)(bufp + S2_QH); const LAS bf16_t* KH = (const LAS bf16_t*)(bufp + S2_KH);
            const LAS bf16_t* KT = (const LAS bf16_t*)(bufp + S2_KT); const LAS bf16_t* VTT = (const LAS bf16_t*)(bufp + S2_VT);
            const LAS float* ETOT = (const LAS float*)(lds + S2_ETOT) + (cs & 1) * 128;
            f32x16 o, o2;
#pragma unroll
            for (int i = 0; i < 16; ++i) { o[i] = 0.f; o2[i] = 0.f; }
            const int di = (wb - 1) & 1;
            if (wb == 0) {
#pragma unroll
                for (int ks = 0; ks < 8; ks += 2) {
                    o = MFMA32(*(const LAS bf16x8*)(KH + r * S2_LD + 16 * ks + 8 * hh), *(const LAS bf16x8*)(QH + r * S2_LD + 16 * ks + 8 * hh), o);
                    o2 = MFMA32(*(const LAS bf16x8*)(KH + r * S2_LD + 16 * (ks + 1) + 8 * hh), *(const LAS bf16x8*)(QH + r * S2_LD + 16 * (ks + 1) + 8 * hh), o2);
                }
#pragma unroll
                for (int q4 = 0; q4 < 4; ++q4) {
                    const int s0 = 8 * q4 + 4 * hh;
                    float pv[4];
#pragma unroll
                    for (int e = 0; e < 4; ++e) { const int sr = s0 + e; const bool keep = DIR == 0 ? (sr <= r) : (sr >= r); pv[e] = keep ? (o[4 * q4 + e] + o2[4 * q4 + e]) : 0.f; }
                    u32x2 wv; wv.x = pk2(pv[0], pv[1]); wv.y = pk2(pv[2], pv[3]);
                    *(LAS u32x2*)(PL + r * S2_LDC + s0) = wv;
                }
            } else if (wb < 3) {
#pragma unroll
                for (int ks = 0; ks < 8; ks += 2) {
                    o = MFMA32(*(const LAS bf16x8*)(QT + r * S2_LD + 16 * ks + 8 * hh), *(const LAS bf16x8*)(ST + (32 * di + r) * S2_LD + 16 * ks + 8 * hh), o);
                    o2 = MFMA32(*(const LAS bf16x8*)(QT + r * S2_LD + 16 * (ks + 1) + 8 * hh), *(const LAS bf16x8*)(ST + (32 * di + r) * S2_LD + 16 * (ks + 1) + 8 * hh), o2);
                }
            }
            LDS_BAR();
            if (wb == 1 || wb == 2) {
                o = MFMA32(*(const LAS bf16x8*)(PL + r * S2_LDC + 8 * hh), *(const LAS bf16x8*)(VTT + (32 * di + r) * S2_LDC + 8 * hh), o);
                o2 = MFMA32(*(const LAS bf16x8*)(PL + r * S2_LDC + 16 + 8 * hh), *(const LAS bf16x8*)(VTT + (32 * di + r) * S2_LDC + 16 + 8 * hh), o2);
                char* o_u = (char*)OD + (tokbase + 32 * c) * 1024 + (h * 128 + half * 64 + 32 * di) * 2;
                const unsigned o_off = (unsigned)hh * 4096u + 2u * (unsigned)r;
#pragma unroll
                for (int i = 0; i < 16; ++i) { const int tr = (i & 3) + 8 * (i >> 2); *(bf16_t*)(o_u + tr * 1024 + o_off) = (bf16_t)(pk2(o[i] + o2[i], 0.f) & 0xffffu); }
            }
            {
#pragma unroll
                for (int q4 = 0; q4 < 4; ++q4) {
                    const f32x4 et = *(const LAS f32x4*)(ETOT + 32 * wb + 8 * q4 + 4 * hh);
#pragma unroll
                    for (int e = 0; e < 4; ++e) { sacc0[4 * q4 + e] *= et[e]; sacc1[4 * q4 + e] *= et[e]; }
                }
#pragma unroll
                for (int ks = 0; ks < 2; ++ks) {
                    const bf16x8 a = *(const LAS bf16x8*)(KT + (32 * wb + r) * S2_LDC + 16 * ks + 8 * hh);
                    sacc0 = MFMA32(a, *(const LAS bf16x8*)(VTT + r * S2_LDC + 16 * ks + 8 * hh), sacc0);
                    sacc1 = MFMA32(a, *(const LAS bf16x8*)(VTT + (32 + r) * S2_LDC + 16 * ks + 8 * hh), sacc1);
                }
#pragma unroll
                for (int q4 = 0; q4 < 4; ++q4) {
                    u32x2 w0, w1; w0.x = pk2(sacc0[4 * q4], sacc0[4 * q4 + 1]); w0.y = pk2(sacc0[4 * q4 + 2], sacc0[4 * q4 + 3]);
                    w1.x = pk2(sacc1[4 * q4], sacc1[4 * q4 + 1]); w1.y = pk2(sacc1[4 * q4 + 2], sacc1[4 * q4 + 3]);
                    *(LAS u32x2*)(ST + r * S2_LD + 32 * wb + 8 * q4 + 4 * hh) = w0;
                    *(LAS u32x2*)(ST + (32 + r) * S2_LD + 32 * wb + 8 * q4 + 4 * hh) = w1;
                }
            }
            LDS_BAR();
        }
    }
    LDS_BAR();
}

constexpr int AT_K = 0, AT_V = 61440, AT_RP = 122880 + 256;
__device__ __forceinline__ void phase_attn(const Params& P, LAS unsigned char* lds) {
    const int tid = threadIdx.x, wave = __builtin_amdgcn_readfirstlane(tid >> 6), lane = tid & 63;
    const int qi = lane & 15, g = lane >> 4;
    const bf16_t* Q = (const bf16_t*)(P.ws + OFF_Q); const bf16_t* Kp = (const bf16_t*)(P.ws + OFF_K);
    const bf16_t* VT = (const bf16_t*)(P.ws + OFF_VT); const bf16_t* SG = (const bf16_t*)(P.ws + OFF_SG);
    bf16_t* mix = (bf16_t*)(P.ws + OFF_MIX);
    LAS float* rpl = (LAS float*)(lds + AT_RP);
    const int jrow = 8 * (qi >> 2) + (qi & 3);
    u32x4 pk_[8], pv_[8];
#define AT_ISSUE(rnd_) do { const int h_ = (rnd_) & 7, n_ = ((rnd_) >> 3) & 3, rh_ = ((rnd_) >> 5) & 7, b_ = (rnd_) >> 8; \
        const int R0_ = min(max(8 * rh_ - 4, 0), 49), bs_ = min(max(16 * n_ - 8, 0), 32); \
        const bf16_t* kt_ = Kp + ((size_t)(b_ * 8 + h_) * 4096 + R0_ * 64 + bs_) * 64; \
        const bf16_t* vt_ = VT + ((size_t)(b_ * 8 + h_) * 64 + R0_) * 4096 + bs_; \
        _Pragma("unroll") for (int i = 0; i < 8; ++i) { const int q = tid + 512 * i; if (q < 3840) { \
            pk_[i] = *(const u32x4*)(kt_ + (q >> 8) * 4096 + ((q >> 3) & 31) * 64 + (q & 7) * 8); \
            pv_[i] = *(const u32x4*)(vt_ + (q >> 8) * 4096 + ((q >> 2) & 63) * 64 + (q & 3) * 8); } } } while (0)
    bf16x8 qn[2]; u32x2 gn[4];
#define AT_ISSUE_Q(rnd_) do { const int h_ = (rnd_) & 7, n_ = ((rnd_) >> 3) & 3, rr_ = (((rnd_) >> 5) & 7) * 8 + wave, b_ = (rnd_) >> 8; \
        const bf16_t* qq_ = Q + ((size_t)(b_ * 8 + h_) * 4096 + rr_ * 64 + 16 * n_) * 64 + qi * 64 + 8 * g; \
        const bf16_t* sg_ = SG + ((size_t)b_ * 4096 + rr_ * 64 + 16 * n_) * 512 + h_ * 64 + qi * 512 + 4 * g; \
        qn[0] = *(const bf16x8*)qq_; qn[1] = *(const bf16x8*)(qq_ + 32); \
        gn[0] = *(const u32x2*)sg_; gn[1] = *(const u32x2*)(sg_ + 16); gn[2] = *(const u32x2*)(sg_ + 32); gn[3] = *(const u32x2*)(sg_ + 48); } while (0)
    int rnd = blockIdx.x;
    if (rnd < 4096) { AT_ISSUE(rnd); AT_ISSUE_Q(rnd); }
    for (; rnd < 4096; rnd += gridDim.x) {
        const int h = rnd & 7, n = (rnd >> 3) & 3, rh = (rnd >> 5) & 7, b = rnd >> 8;
        const int R0 = min(max(8 * rh - 4, 0), 49), bs = min(max(16 * n - 8, 0), 32);
        __syncthreads();
#pragma unroll
        for (int i = 0; i < 8; ++i) { const int q = tid + 512 * i; if (q < 3840) {
            const int col = (q >> 3) & 31, d = (q >> 2) & 63;
            *(LAS u32x4*)(lds + AT_K + ((q >> 8) * 32 + col) * 128 + (((q & 7) ^ (((col >> 1) & 1) | (((col >> 3) & 3) << 1))) * 16)) = pk_[i];
            *(LAS u32x4*)(lds + AT_V + ((q >> 8) * 64 + d) * 64 + (((q & 3) ^ ((d >> 2) & 3)) * 16)) = pv_[i]; } }
        if (tid < 465) rpl[tid] = P.rpb[h * 465 + tid] * 1.4426950408889634f;
        __syncthreads();
        const bf16x8 qf[2] = {qn[0], qn[1]};
        const u32x2 gw2[4] = {gn[0], gn[1], gn[2], gn[3]};
        { const int nx = rnd + gridDim.x; if (nx < 4096) { AT_ISSUE(nx); AT_ISSUE_Q(nx); } }
        const int rr = 8 * rh + wave;
        const int rs = min(max(rr - 4, 0), 56), lrow0 = rs - R0;
        const int qc = 16 * n + qi, cs = min(max(qc - 8, 0), 48);
        bf16_t* mix_u = mix + ((size_t)b * 4096 + rr * 64 + 16 * n) * 1024 + h * 64;
        f32x4 sacc[16];
#pragma unroll
        for (int kb = 0; kb < 16; ++kb) {
            const int jc = jrow + 4 * (kb & 1);
            const LAS unsigned char* kr = lds + AT_K + ((lrow0 + (kb >> 1)) * 32 + jc) * 128;
            const int sw = ((jc >> 1) & 1) | (((jc >> 3) & 3) << 1);
            const bf16x8 k0 = *(const LAS bf16x8*)(kr + ((g ^ sw) * 16));
            const bf16x8 k1 = *(const LAS bf16x8*)(kr + (((4 + g) ^ sw) * 16));
            sacc[kb] = MFMA16(k0, qf[0], ((f32x4){0.f, 0.f, 0.f, 0.f}));
            sacc[kb] = MFMA16(k1, qf[1], sacc[kb]);
        }
        const LAS float* rp = rpl + (rs - rr + 7) * 31 + (bs + 8 * g - qc + 15);
        const int kc0 = bs + 8 * g;
        float mx = -INFINITY;
#pragma unroll
        for (int kb = 0; kb < 16; ++kb) {
#pragma unroll
            for (int j = 0; j < 4; ++j) {
                const int kc = kc0 + 4 * (kb & 1) + j;
                const bool valid = (kc >= cs) && (kc < cs + 16);
                float s = sacc[kb][j] + rp[(kb >> 1) * 31 + 4 * (kb & 1) + j];
                s = valid ? s : -INFINITY;
                sacc[kb][j] = s; mx = fmaxf(mx, s);
            }
        }
        mx = fmaxf(mx, __shfl_xor(mx, 16)); mx = fmaxf(mx, __shfl_xor(mx, 32));
        float sum = 0.f;
#pragma unroll
        for (int kb = 0; kb < 16; ++kb)
#pragma unroll
            for (int j = 0; j < 4; ++j) { const float pe = __builtin_amdgcn_exp2f(sacc[kb][j] - mx); sacc[kb][j] = pe; sum += pe; }
        sum += __shfl_xor(sum, 16); sum += __shfl_xor(sum, 32);
        f32x4 oacc[4];
#pragma unroll
        for (int db = 0; db < 4; ++db) oacc[db] = (f32x4){0.f, 0.f, 0.f, 0.f};
#pragma unroll
        for (int c = 0; c < 8; ++c) {
            u32x4 pw; pw.x = pk2(sacc[2 * c][0], sacc[2 * c][1]); pw.y = pk2(sacc[2 * c][2], sacc[2 * c][3]);
            pw.z = pk2(sacc[2 * c + 1][0], sacc[2 * c + 1][1]); pw.w = pk2(sacc[2 * c + 1][2], sacc[2 * c + 1][3]);
            const bf16x8 pf = __builtin_bit_cast(bf16x8, pw);
#pragma unroll
            for (int db = 0; db < 4; ++db) {
                const int d = db * 16 + qi;
                const bf16x8 vfr = *(const LAS bf16x8*)(lds + AT_V + ((lrow0 + c) * 64 + d) * 64 + ((g ^ ((d >> 2) & 3)) * 16));
                oacc[db] = MFMA16(vfr, pf, oacc[db]);
            }
        }
        const float inv = __builtin_amdgcn_rcpf(sum);
        float ssq = 0.f;
#pragma unroll
        for (int db = 0; db < 4; ++db)
#pragma unroll
            for (int j = 0; j < 4; ++j) { const float ov = oacc[db][j] * inv; oacc[db][j] = ov; ssq += ov * ov; }
        ssq += __shfl_xor(ssq, 16); ssq += __shfl_xor(ssq, 32);
        const float rn = rsqrtf(ssq * (1.0f / 64.0f) + EPS);
#pragma unroll
        for (int db = 0; db < 4; ++db) {
            const int col = h * 64 + db * 16 + 4 * g;
            const f32x4 an = *(const f32x4*)(P.attn_norm + col);
            u32x2 wv;
            wv.x = pk2(oacc[db][0] * rn * an[0] * siluf_(bf_lo(gw2[db].x)), oacc[db][1] * rn * an[1] * siluf_(bf_hi(gw2[db].x)));
            wv.y = pk2(oacc[db][2] * rn * an[2] * siluf_(bf_lo(gw2[db].y)), oacc[db][3] * rn * an[3] * siluf_(bf_hi(gw2[db].y)));
            *(u32x2*)(mix_u + db * 16 + qi * 1024 + 4 * g) = wv;
        }
    }
    __syncthreads();
#undef AT_ISSUE
#undef AT_ISSUE_Q
}

__device__ __forceinline__ void phase_hpost(const Params& P) {
    const int tid = threadIdx.x, wave = tid >> 6, lane = tid & 63;
    const int gw = blockIdx.x * 8 + wave, NGW = gridDim.x * 8;
    const bf16_t* O0 = (const bf16_t*)(P.ws + OFF_OD); const bf16_t* O1 = (const bf16_t*)(P.ws + OFF_OD + 64 * MiB);
    const bf16_t* SHG = (const bf16_t*)(P.ws + OFF_SHG);
    bf16_t* mix = (bf16_t*)(P.ws + OFF_MIX);
    const int c0 = 8 * lane;
    const f32x4 n0 = *(const f32x4*)(P.hgrn_norm + c0), n1 = *(const f32x4*)(P.hgrn_norm + c0 + 4);
    const float nw[8] = {n0[0], n0[1], n0[2], n0[3], n1[0], n1[1], n1[2], n1[3]};
    for (int tok = gw; tok < NTOK; tok += NGW) {
        const u32x4 a = *(const u32x4*)(O0 + (size_t)tok * 512 + c0), bq = *(const u32x4*)(O1 + (size_t)tok * 512 + c0), gt = *(const u32x4*)(SHG + (size_t)tok * 512 + c0);
        float v[8] = {bf_lo(a.x) + bf_lo(bq.x), bf_hi(a.x) + bf_hi(bq.x), bf_lo(a.y) + bf_lo(bq.y), bf_hi(a.y) + bf_hi(bq.y),
                      bf_lo(a.z) + bf_lo(bq.z), bf_hi(a.z) + bf_hi(bq.z), bf_lo(a.w) + bf_lo(bq.w), bf_hi(a.w) + bf_hi(bq.w)};
        const float gv[8] = {bf_lo(gt.x), bf_hi(gt.x), bf_lo(gt.y), bf_hi(gt.y), bf_lo(gt.z), bf_hi(gt.z), bf_lo(gt.w), bf_hi(gt.w)};
        float s = 0.f;
#pragma unroll
        for (int e = 0; e < 8; ++e) s += v[e] * v[e];
        s += __shfl_xor(s, 1); s += __shfl_xor(s, 2); s += __shfl_xor(s, 4); s += __shfl_xor(s, 8);
        const float rn = rsqrtf(s * (1.0f / 128.0f) + EPS);
#pragma unroll
        for (int e = 0; e < 8; ++e) v[e] = v[e] * rn * nw[e] * gv[e];
        u32x4 wv; wv.x = pk2(v[0], v[1]); wv.y = pk2(v[2], v[3]); wv.z = pk2(v[4], v[5]); wv.w = pk2(v[6], v[7]);
        *(u32x4*)(mix + (size_t)tok * 1024 + 512 + c0) = wv;
    }
}

__device__ __forceinline__ void phase_final(const Params& P) {
    const int tid = threadIdx.x, wave = tid >> 6, lane = tid & 63;
    const int gw = blockIdx.x * 8 + wave, NGW = gridDim.x * 8;
    const float* ss3 = (const float*)(P.ws + OFF_SS3);
    f32x4 lw[4];
#pragma unroll
    for (int j = 0; j < 4; ++j) lw[j] = ((const f32x4*)P.ln_final)[lane + 64 * j];
    for (int row = gw; row < NTOK; row += NGW) {
        const float rs = rsqrtf(ss3[row] * (1.0f / 1024.0f) + EPS);
        f32x4* o = (f32x4*)(P.out + (size_t)row * 1024) + lane;
#pragma unroll
        for (int j = 0; j < 4; ++j) { f32x4 v = o[64 * j]; v = v * rs * lw[j]; o[64 * j] = v; }
    }
}

#define BLOCK_HANDOFF() do { __builtin_amdgcn_fence(__ATOMIC_RELEASE, "workgroup"); __syncthreads(); __builtin_amdgcn_fence(__ATOMIC_ACQUIRE, "workgroup"); } while (0)
__device__ __forceinline__ void phase_tail(const Params& P, LAS unsigned char* lds) {
    const int tid = threadIdx.x, wave = __builtin_amdgcn_readfirstlane(tid >> 6), lane = tid & 63;
    LAS float* ss2l = (LAS float*)(lds + 131072); LAS float* ss3l = ss2l + 256;
    const bf16_t* O0 = (const bf16_t*)(P.ws + OFF_OD); const bf16_t* O1 = (const bf16_t*)(P.ws + OFF_OD + 64 * MiB);
    const bf16_t* SHG = (const bf16_t*)(P.ws + OFF_SHG);
    bf16_t* mix = (bf16_t*)(P.ws + OFF_MIX);
    {
        const int panel = blockIdx.x;
        __syncthreads();
        ss2l[tid] = 0.f;
        const bool odd = (blockIdx.x & 1) != 0;
        if (odd) { __syncthreads();
        {
            bf16_t* pb = (bf16_t*)(P.ws + OFF_PB);
#pragma unroll 8
            for (int i = 0; i < 32; ++i) {
                const size_t row = (size_t)panel * 256 + wave * 32 + i;
                const f32x4 v = ((const f32x4*)(P.p + row * 256))[lane];
                u32x2 w; w.x = pk2(v[0], v[1]); w.y = pk2(v[2], v[3]);
                ((u32x2*)(pb + row * 256))[lane] = w;
            }
            BLOCK_HANDOFF();
        }
        {
            pg8::PanelOrder S{panel, 4};
            pg8::Gemm g{(const bf16_t*)(P.ws + OFF_PB), (const bf16_t*)(P.ws + OFF_W4T), NTOK, 1024, 256};
            EpiPP E{(bf16_t*)(P.ws + OFF_PP)};
            pg8::gemm_phase(lds, g, S, E);
        }
        }
        {
            const int c0 = 8 * lane;
            const f32x4 n0 = *(const f32x4*)(P.hgrn_norm + c0), n1 = *(const f32x4*)(P.hgrn_norm + c0 + 4);
            const float nw[8] = {n0[0], n0[1], n0[2], n0[3], n1[0], n1[1], n1[2], n1[3]};
#pragma unroll 8
            for (int i = 0; i < 32; ++i) {
                const size_t tok = (size_t)panel * 256 + wave * 32 + i;
                const u32x4 a = *(const u32x4*)(O0 + tok * 512 + c0), bq = *(const u32x4*)(O1 + tok * 512 + c0), gt = *(const u32x4*)(SHG + tok * 512 + c0);
                float v[8] = {bf_lo(a.x) + bf_lo(bq.x), bf_hi(a.x) + bf_hi(bq.x), bf_lo(a.y) + bf_lo(bq.y), bf_hi(a.y) + bf_hi(bq.y),
                              bf_lo(a.z) + bf_lo(bq.z), bf_hi(a.z) + bf_hi(bq.z), bf_lo(a.w) + bf_lo(bq.w), bf_hi(a.w) + bf_hi(bq.w)};
                const float gv[8] = {bf_lo(gt.x), bf_hi(gt.x), bf_lo(gt.y), bf_hi(gt.y), bf_lo(gt.z), bf_hi(gt.z), bf_lo(gt.w), bf_hi(gt.w)};
                float s = 0.f;
#pragma unroll
                for (int e = 0; e < 8; ++e) s += v[e] * v[e];
                s += __shfl_xor(s, 1); s += __shfl_xor(s, 2); s += __shfl_xor(s, 4); s += __shfl_xor(s, 8);
                const float rn = rsqrtf(s * (1.0f / 128.0f) + EPS);
#pragma unroll
                for (int e = 0; e < 8; ++e) v[e] = v[e] * rn * nw[e] * siluf_(gv[e]);
                u32x4 wv; wv.x = pk2(v[0], v[1]); wv.y = pk2(v[2], v[3]); wv.z = pk2(v[4], v[5]); wv.w = pk2(v[6], v[7]);
                *(u32x4*)(mix + tok * 1024 + 512 + c0) = wv;
            }
        }
        BLOCK_HANDOFF();
        {
            pg8::PanelOrder S{panel, 4};
            pg8::Gemm g{(const bf16_t*)(P.ws + OFF_MIX), (const bf16_t*)(P.ws + OFF_W2T), NTOK, 1024, 1024};
            Epi2P E{P.x, P.out, (bf16_t*)(P.ws + OFF_HB), ss2l};
            pg8::gemm_phase(lds, g, S, E);
        }
        if (!odd) {
        {
            bf16_t* pb = (bf16_t*)(P.ws + OFF_PB);
#pragma unroll 8
            for (int i = 0; i < 32; ++i) {
                const size_t row = (size_t)panel * 256 + wave * 32 + i;
                const f32x4 v = ((const f32x4*)(P.p + row * 256))[lane];
                u32x2 w; w.x = pk2(v[0], v[1]); w.y = pk2(v[2], v[3]);
                ((u32x2*)(pb + row * 256))[lane] = w;
            }
            BLOCK_HANDOFF();
        }
        {
            pg8::PanelOrder S{panel, 4};
            pg8::Gemm g{(const bf16_t*)(P.ws + OFF_PB), (const bf16_t*)(P.ws + OFF_W4T), NTOK, 1024, 256};
            EpiPP E{(bf16_t*)(P.ws + OFF_PP)};
            pg8::gemm_phase(lds, g, S, E);
        }
        }
        BLOCK_HANDOFF();
        {
            pg8::PanelOrder S{panel, 4};
            pg8::Gemm g{(const bf16_t*)(P.ws + OFF_HB), (const bf16_t*)(P.ws + OFF_W3T), NTOK, 1024, 1024};
            Epi3P E{(bf16_t*)(P.ws + OFF_HFB), (const bf16_t*)(P.ws + OFF_PP), (const bf16_t*)(P.ws + OFF_HB), ss2l, ss3l};
            pg8::gemm_phase(lds, g, S, E);
        }
        BLOCK_HANDOFF();
        {
            const bf16_t* hfb = (const bf16_t*)(P.ws + OFF_HFB);
            f32x4 lw[4];
#pragma unroll
            for (int j = 0; j < 2; ++j) { lw[2 * j] = *(const f32x4*)(P.ln_final + lane * 8 + 512 * j); lw[2 * j + 1] = *(const f32x4*)(P.ln_final + lane * 8 + 512 * j + 4); }
#pragma unroll 8
            for (int i = 0; i < 32; ++i) {
                const int lrow = wave * 32 + i;
                const float rs = rsqrtf(ss3l[lrow] * (1.0f / 1024.0f) + EPS);
                const size_t ro = ((size_t)panel * 256 + lrow) * 1024 + lane * 8;
                const u32x4 a = *(const u32x4*)(hfb + ro), bq = *(const u32x4*)(hfb + ro + 512);
                f32x4 v0 = {bf_lo(a.x), bf_hi(a.x), bf_lo(a.y), bf_hi(a.y)}, v1 = {bf_lo(a.z), bf_hi(a.z), bf_lo(a.w), bf_hi(a.w)};
                f32x4 v2 = {bf_lo(bq.x), bf_hi(bq.x), bf_lo(bq.y), bf_hi(bq.y)}, v3 = {bf_lo(bq.z), bf_hi(bq.z), bf_lo(bq.w), bf_hi(bq.w)};
                *(f32x4*)(P.out + ro) = v0 * rs * lw[0]; *(f32x4*)(P.out + ro + 4) = v1 * rs * lw[1];
                *(f32x4*)(P.out + ro + 512) = v2 * rs * lw[2]; *(f32x4*)(P.out + ro + 516) = v3 * rs * lw[3];
            }
        }
    }
}

template <int PH> __device__ __forceinline__ void run_phase(const Params& P, LAS unsigned char* lds) {
    if constexpr (PH == 0) {
        phase_prep(P);
    } else if constexpr (PH == 1) {
        pg8::StaticOrder S; S.init(NTOK, 4608, (int)gridDim.x, (int)blockIdx.x);
        pg8::Gemm g{(const bf16_t*)(P.ws + OFF_XB), (const bf16_t*)(P.ws + OFF_W1T), NTOK, 4608, 1024};
        Epi1 E{P.ws};
        pg8::gemm_phase(lds, g, S, E);
    } else if constexpr (PH == 2) {
#ifndef SKIP_SCAN
        for (int task = blockIdx.x; task < 256; task += gridDim.x) { if (task >> 7) hgrn_scan2<1>(P, lds, task); else hgrn_scan2<0>(P, lds, task); }
#if PROBE_DUP == 20
        for (int task = blockIdx.x; task < 256; task += gridDim.x) { if (task >> 7) hgrn_scan2<1>(P, lds, task); else hgrn_scan2<0>(P, lds, task); }
#endif
#else
        { u32x4* od = (u32x4*)(P.ws + OFF_OD); for (size_t i = (size_t)blockIdx.x * 512 + threadIdx.x; i < (128 * MiB) / 16; i += (size_t)gridDim.x * 512) od[i] = (u32x4){0u, 0u, 0u, 0u}; }
#endif
        phase_attn(P, lds);
#if PROBE_DUP == 21
        phase_attn(P, lds);
#endif
    } else if constexpr (PH == 3) {
        phase_hpost(P);
        __syncthreads();
        pg8::StaticOrder S; S.init(NTOK, 1024, (int)gridDim.x, (int)blockIdx.x);
        pg8::Gemm g{(const bf16_t*)(P.ws + OFF_PB), (const bf16_t*)(P.ws + OFF_W4T), NTOK, 1024, 256};
        EpiPP E{(bf16_t*)(P.ws + OFF_PP)};
        pg8::gemm_phase(lds, g, S, E);
    } else if constexpr (PH == 4) {
        pg8::StaticOrder S; S.init(NTOK, 1024, (int)gridDim.x, (int)blockIdx.x);
        pg8::Gemm g{(const bf16_t*)(P.ws + OFF_MIX), (const bf16_t*)(P.ws + OFF_W2T), NTOK, 1024, 1024};
        Epi2 E{P.x, P.out, (bf16_t*)(P.ws + OFF_HB), (float*)(P.ws + OFF_SS2)};
        pg8::gemm_phase(lds, g, S, E);
    } else if constexpr (PH == 5) {
        pg8::StaticOrder S; S.init(NTOK, 1024, (int)gridDim.x, (int)blockIdx.x);
        pg8::Gemm g{(const bf16_t*)(P.ws + OFF_HB), (const bf16_t*)(P.ws + OFF_W3T), NTOK, 1024, 1024};
        Epi3 E{P.out, (const bf16_t*)(P.ws + OFF_PP), (const float*)(P.ws + OFF_SS2), (float*)(P.ws + OFF_SS3)};
        pg8::gemm_phase(lds, g, S, E);
    } else {
        phase_final(P);
    }
}
#if N_LAUNCHES == 1
__global__ __launch_bounds__(512, 2) void fwd_kernel(Params P) {
    extern __shared__ __attribute__((aligned(16))) unsigned char shm[];
    LAS unsigned char* lds = (LAS unsigned char*)shm;
    cg::grid_group grid = cg::this_grid();
    volatile LAS unsigned* xst = (volatile LAS unsigned*)(lds + 131072 + 2048);
    if (threadIdx.x == 0) { xst[0] = 0u; xst[1] = 0u; }
    __syncthreads();
    const XcdBarrier xb = xcd_barrier_post((unsigned*)(P.ws + OFF_BAR), xst);
    run_phase<0>(P, lds); xcd_barrier(xb);
    run_phase<1>(P, lds); xcd_barrier(xb);
    run_phase<2>(P, lds); xcd_barrier(xb);
    phase_tail(P, lds);
    if (P.ws == nullptr) grid.sync();
}
#else
template <int PH> __global__ __launch_bounds__(512, 2) void k_ph(Params P) {
    extern __shared__ __attribute__((aligned(16))) unsigned char shm[];
    run_phase<PH>(P, (LAS unsigned char*)shm);
}
#endif

extern "C" void kernel_launch(void* const* d_in, const int* in_sizes, int n_in, void* d_out, int out_size, void* d_ws, size_t ws_size, hipStream_t stream) {
    static int grid = 0;
    if (grid == 0) {
        if (n_in != 13 || out_size != NTOK * DM || ws_size < WS_END) { fprintf(stderr, "kernel_launch: unexpected shapes (n_in %d out %d ws %zu)\n", n_in, out_size, ws_size); grid = -1; return; }
        int dev = 0, cus = 0;
        (void)hipGetDevice(&dev);
        (void)hipDeviceGetAttribute(&cus, hipDeviceAttributeMultiprocessorCount, dev);
        bool ok = true;
#if N_LAUNCHES == 1
        ok = ok && hipFuncSetAttribute((const void*)fwd_kernel, hipFuncAttributeMaxDynamicSharedMemorySize, LDS_BYTES) == hipSuccess;
        int per_cu = 0;
        (void)hipOccupancyMaxActiveBlocksPerMultiprocessor(&per_cu, (const void*)fwd_kernel, 512, LDS_BYTES);
        if (per_cu < 1) fprintf(stderr, "kernel_launch: occupancy query says %d blocks per CU\n", per_cu);
#else
        ok = ok && hipFuncSetAttribute((const void*)k_ph<0>, hipFuncAttributeMaxDynamicSharedMemorySize, LDS_BYTES) == hipSuccess;
        ok = ok && hipFuncSetAttribute((const void*)k_ph<1>, hipFuncAttributeMaxDynamicSharedMemorySize, LDS_BYTES) == hipSuccess;
        ok = ok && hipFuncSetAttribute((const void*)k_ph<2>, hipFuncAttributeMaxDynamicSharedMemorySize, LDS_BYTES) == hipSuccess;
        ok = ok && hipFuncSetAttribute((const void*)k_ph<3>, hipFuncAttributeMaxDynamicSharedMemorySize, LDS_BYTES) == hipSuccess;
        ok = ok && hipFuncSetAttribute((const void*)k_ph<4>, hipFuncAttributeMaxDynamicSharedMemorySize, LDS_BYTES) == hipSuccess;
        ok = ok && hipFuncSetAttribute((const void*)k_ph<5>, hipFuncAttributeMaxDynamicSharedMemorySize, LDS_BYTES) == hipSuccess;
        ok = ok && hipFuncSetAttribute((const void*)k_ph<6>, hipFuncAttributeMaxDynamicSharedMemorySize, LDS_BYTES) == hipSuccess;
#endif
        (void)hipGetLastError();
        if (!ok) { fprintf(stderr, "kernel_launch: hipFuncSetAttribute failed\n"); grid = -1; return; }
        grid = 256;
        if (cus < 256) { fprintf(stderr, "kernel_launch: needs 256 CUs (one 256-row panel per workgroup), device has %d\n", cus); grid = -1; return; }
    }
    if (grid < 0) return;
    Params P{};
    P.x = (const float*)d_in[0]; P.p = (const float*)d_in[1]; P.ln_mix = (const float*)d_in[2]; P.w_in = (const float*)d_in[3]; P.rpb = (const float*)d_in[4];
    P.lb_logits = (const float*)d_in[5]; P.attn_norm = (const float*)d_in[6]; P.hgrn_norm = (const float*)d_in[7]; P.w_out = (const float*)d_in[8];
    P.ln_ple = (const float*)d_in[9]; P.w_pg = (const float*)d_in[10]; P.w_pp = (const float*)d_in[11]; P.ln_final = (const float*)d_in[12];
    P.out = (float*)d_out; P.ws = (unsigned char*)d_ws;
#if N_LAUNCHES == 1
    if (hipMemsetAsync((char*)d_ws + OFF_BAR, 0, XCD_BAR_WORDS * sizeof(unsigned), stream) != hipSuccess) { fprintf(stderr, "kernel_launch: hipMemsetAsync of the barrier words failed\n"); return; }
    void* args[] = {&P};
    hipError_t e = hipLaunchCooperativeKernel((const void*)fwd_kernel, dim3(grid), dim3(512), args, LDS_BYTES, stream);
    if (e != hipSuccess) fprintf(stderr, "cooperative launch failed: %s (grid %d)\n", hipGetErrorString(e), grid);
#else
    hipLaunchKernelGGL(k_ph<0>, dim3(grid), dim3(512), LDS_BYTES, stream, P);
    hipLaunchKernelGGL(k_ph<1>, dim3(grid), dim3(512), LDS_BYTES, stream, P);
    hipLaunchKernelGGL(k_ph<2>, dim3(grid), dim3(512), LDS_BYTES, stream, P);
    hipLaunchKernelGGL(k_ph<3>, dim3(grid), dim3(512), LDS_BYTES, stream, P);
    hipLaunchKernelGGL(k_ph<4>, dim3(grid), dim3(512), LDS_BYTES, stream, P);
    hipLaunchKernelGGL(k_ph<5>, dim3(grid), dim3(512), LDS_BYTES, stream, P);
    hipLaunchKernelGGL(k_ph<6>, dim3(grid), dim3(512), LDS_BYTES, stream, P);
#endif
}
```

```cpp
#include <hip/hip_runtime.h>
#include <hip/hip_cooperative_groups.h>
#include <cstdio>
namespace cg = cooperative_groups;

#ifndef N_LAUNCHES
#define N_LAUNCHES 1
#define PROBE_DUP -1
#endif

#define LAS __attribute__((address_space(3)))
typedef unsigned short bf16_t;
typedef short bf16x8 __attribute__((ext_vector_type(8)));
typedef float f32x2 __attribute__((ext_vector_type(2)));
typedef float f32x4 __attribute__((ext_vector_type(4)));
typedef float f32x16 __attribute__((ext_vector_type(16)));
typedef unsigned u32x2 __attribute__((ext_vector_type(2)));
typedef unsigned u32x4 __attribute__((ext_vector_type(4)));

constexpr int NTOK = 65536, DM = 1024, SEQ = 4096;
constexpr float EPS = 1e-6f;
constexpr size_t MiB = 1ull << 20;
constexpr size_t OFF_XB = 0, OFF_MIX = 0;
constexpr size_t OFF_Q = 128 * MiB, OFF_K = 192 * MiB, OFF_VT = 256 * MiB, OFF_SG = 320 * MiB, OFF_HQ = 384 * MiB;
constexpr size_t OFF_GF = 448 * MiB  , OFF_HIT = 576 * MiB, OFF_SHG = 640 * MiB;
constexpr size_t OFF_OD = 704 * MiB, OFF_HB = OFF_VT  , OFF_PB = 832 * MiB, OFF_PP = OFF_Q;
constexpr size_t OFF_HFB = OFF_GF  ;
constexpr size_t OFF_W1T = 864 * MiB, OFF_W2T = 873 * MiB, OFF_W3T = 875 * MiB, OFF_W4T = 877 * MiB;
constexpr size_t OFF_RSTD1 = 878 * MiB, OFF_SS2 = OFF_RSTD1 + 256 * 1024, OFF_SS3 = OFF_SS2 + 256 * 1024, OFF_LB = OFF_SS3 + 256 * 1024;
constexpr size_t OFF_BAR = 879 * MiB;
constexpr size_t WS_END = 880 * MiB;
constexpr int LDS_BYTES = 131072 + 2048 + 64;

struct Params {
    const float *x, *p, *ln_mix, *w_in, *rpb, *lb_logits, *attn_norm, *hgrn_norm, *w_out, *ln_ple, *w_pg, *w_pp, *ln_final;
    float* out;
    unsigned char* ws;
};

typedef __bf16 bf16x2v __attribute__((ext_vector_type(2)));
__device__ __forceinline__ unsigned pk2(float lo, float hi) { f32x2 v = {lo, hi}; bf16x2v b = __builtin_convertvector(v, bf16x2v); return __builtin_bit_cast(unsigned, b); }
__device__ __forceinline__ float bf_lo(unsigned u) { return __uint_as_float(u << 16); }
__device__ __forceinline__ float bf_hi(unsigned u) { return __uint_as_float(u & 0xffff0000u); }
__device__ __forceinline__ float bf1(bf16_t u) { return __uint_as_float(((unsigned)u) << 16); }
__device__ __forceinline__ float sigmoidf_(float v) { return __builtin_amdgcn_rcpf(1.0f + __expf(-v)); }
__device__ __forceinline__ float siluf_(float v) { return v * __builtin_amdgcn_rcpf(1.0f + __expf(-v)); }
__device__ __forceinline__ float wave_sum(float v) {
#pragma unroll
    for (int o = 1; o < 64; o <<= 1) v += __shfl_xor(v, o);
    return v;
}
#define LDS_BAR() do { asm volatile("s_waitcnt lgkmcnt(0)" ::: "memory"); __builtin_amdgcn_s_barrier(); asm volatile("" ::: "memory"); } while (0)

#define XB_TMO      128
#define XB_XCNT(j)  (256  + 64 * (j))
#define XB_XSUB(j)  (1280 + 64 * (j))
#define XB_XGEN(j)  (2304 + 64 * (j))
#define XB_TOP      3328
#define XB_TOPGEN   3392
#define XCD_BAR_WORDS 3456
#define XB_SPIN_CAP (1u << 20)
__device__ __forceinline__ unsigned xb_ld(unsigned* p)              { return __hip_atomic_load(p, __ATOMIC_RELAXED, __HIP_MEMORY_SCOPE_AGENT); }
__device__ __forceinline__ unsigned xb_add(unsigned* p, unsigned v) { return __hip_atomic_fetch_add(p, v, __ATOMIC_RELAXED, __HIP_MEMORY_SCOPE_AGENT); }
__device__ __forceinline__ unsigned xb_xcc_id() { return (unsigned)__builtin_amdgcn_s_getreg((3 << 11) | 20) & 0xFu; }
#define XB_SPIN(cond, bar) do { unsigned _sp = 0; while (cond) { __builtin_amdgcn_s_sleep(1); \
    if ((++_sp & 255u) == 0u) { if (xb_ld(&(bar)[XB_TMO])) break; if (_sp > XB_SPIN_CAP) { atomicAdd(&(bar)[XB_TMO], 1u); break; } } } } while (0)
struct XcdBarrier { unsigned* bar; unsigned x; volatile LAS unsigned* st; };
__device__ __forceinline__ XcdBarrier xcd_barrier_post(unsigned* bar, volatile LAS unsigned* st) {
    XcdBarrier b; b.bar = bar; b.x = xb_xcc_id(); b.st = st;
    if (threadIdx.x == 0) (void)xb_add(&bar[XB_XCNT(b.x)], 1u);
    return b;
}
__device__ __forceinline__ void xcd_barrier_complete(unsigned* bar, unsigned x, unsigned& nloc, unsigned& nx) {
    const unsigned G = gridDim.x * gridDim.y * gridDim.z;
    unsigned sum, cnt, mine, sp = 0u;
    for (;;) {
        sum = 0u; cnt = 0u; mine = 0u;
#pragma unroll
        for (unsigned j = 0; j < 16; ++j) { const unsigned c = xb_ld(&bar[XB_XCNT(j)]); sum += c; cnt += (c > 0u) ? 1u : 0u; mine = (j == x) ? c : mine; }
        if (sum == G) break;
        __builtin_amdgcn_s_sleep(1);
        if ((++sp & 255u) == 0u) { if (xb_ld(&bar[XB_TMO])) break; if (sp > XB_SPIN_CAP) { atomicAdd(&bar[XB_TMO], 1u); break; } }
    }
    nloc = mine > 0u ? mine : 1u; nx = cnt > 0u ? cnt : 1u;
}
__device__ __forceinline__ void xcd_barrier(const XcdBarrier& b) {
    asm volatile("s_waitcnt vmcnt(0)" ::: "memory");
    __syncthreads();
    if (threadIdx.x == 0) {
        unsigned* bar = b.bar;
        __builtin_amdgcn_s_waitcnt(0);
        unsigned nloc = b.st[0], nx = b.st[1];
        if (nloc == 0u) { xcd_barrier_complete(bar, b.x, nloc, nx); b.st[0] = nloc; b.st[1] = nx; }
        const unsigned old = xb_add(&bar[XB_XSUB(b.x)], 1u);
        const unsigned gen = old / nloc;
        if (old + 1u == (gen + 1u) * nloc) {
            __builtin_amdgcn_fence(__ATOMIC_RELEASE, "agent");
            asm volatile("s_waitcnt vmcnt(0)" ::: "memory");
            const unsigned og = xb_add(&bar[XB_TOP], 1u);
            const unsigned tg = og / nx;
            if (og + 1u == (tg + 1u) * nx) xb_add(&bar[XB_TOPGEN], 1u);
            else XB_SPIN(xb_ld(&bar[XB_TOPGEN]) == tg, bar);
            __builtin_amdgcn_fence(__ATOMIC_ACQUIRE, "agent");
            xb_add(&bar[XB_XGEN(b.x)], 1u);
            asm volatile("s_waitcnt vmcnt(0)" ::: "memory");
        } else {
            XB_SPIN(xb_ld(&bar[XB_XGEN(b.x)]) == gen, bar);
            __builtin_amdgcn_fence(__ATOMIC_ACQUIRE, "agent");
            asm volatile("s_waitcnt vmcnt(0)" ::: "memory");
        }
    }
    __syncthreads();
}

namespace pg8 {
constexpr int BM = 256, BK = 64, HALF = 128, HTB = HALF * BK * 2, STAGE_BYTES = 8 * HTB, NXCD = 8, WGM = 8;
__device__ __forceinline__ int lds_byte(int r, int c) { const int st = (r >> 4) * 2 + (c >> 5), rr = r & 15, cc = c & 31, ob = rr * 64 + cc * 2; return st * 1024 + (ob ^ (((ob >> 9) & 1) << 5)); }
__device__ __forceinline__ void stage_rc(int b, int& R, int& C) { const int st = b / 1024, sb = b % 1024, swz = sb ^ (((sb >> 9) & 1) << 5); R = (st >> 1) * 16 + swz / 64; C = (st & 1) * 32 + (swz % 64) / 2; }
__device__ __forceinline__ int perm32(int rho) { const int n = rho >> 4, i = rho & 15; return 8 * (i >> 2) + 4 * n + (i & 3); }
struct Unit { int pm, pn; };
struct Gemm { const bf16_t* A; const bf16_t* Bt; int M, N, K; };
struct StaticOrder {
    int nM, nN, nwg, G, c;
    __device__ void init(int M, int N, int G_, int c_) { nM = M / BM; nN = N / BM; nwg = nM * nN; G = G_; c = c_; }
    __device__ bool next(int i, Unit& u) const {
        const long L = (long)i * G + c; if (L >= nwg) return false;
        int wgid = (int)L; { const int q = nwg / NXCD, r = nwg % NXCD, xcd = wgid % NXCD, off = wgid / NXCD; wgid = (xcd < r ? xcd * (q + 1) : r * (q + 1) + (xcd - r) * q) + off; }
        const int nig = WGM * nN, gid = wgid / nig, fm = gid * WGM, gsz = (nM - fm) < WGM ? (nM - fm) : WGM;
        u.pm = fm + ((wgid % nig) % gsz); u.pn = (wgid % nig) / gsz; return true;
    }
};
template <class Epi, class Sched>
__device__ __forceinline__ void gemm_phase(LAS unsigned char* lds, const Gemm g, const Sched& S, const Epi& E) {
    int tid_ = threadIdx.x; asm volatile("" : "+v"(tid_));
    const int tid = tid_, wid = __builtin_amdgcn_readfirstlane(tid >> 6), lane = tid & 63, wr = wid >> 2, wc = wid & 3, fr = lane & 15, fq = lane >> 4;
    const int K = g.K, nt = K / BK;
    unsigned voffA[2], voffB[2];
#pragma unroll
    for (int i = 0; i < 2; ++i) { int R, C; stage_rc(tid * 16 + i * 8192, R, C); const int Rb = (R & ~31) + perm32(R & 31);
        voffA[i] = (unsigned)(R * K + C) * 2u; voffB[i] = (unsigned)(Rb * K + C) * 2u; }
    const size_t kstep = (size_t)(BK * 2);
    const size_t hstep = (size_t)HALF * K * 2;
    const size_t tstep = 2 * hstep;
    const unsigned ldsw = (unsigned)wid * 1024u;
    const int aoff = lds_byte(wr * 64 + fr, fq * 8), boff = lds_byte(wc * 32 + fr, fq * 8);
#define PG8_SA(b, h) (((b) * 2 + (h)) * HTB)
#define PG8_SB(b, h) ((4 + (b) * 2 + (h)) * HTB)
#define PG8_STAGE(bufoff, gbase, voff) do { _Pragma("unroll") for (int _i = 0; _i < 2; ++_i) \
        __builtin_amdgcn_global_load_lds((const unsigned*)((const char*)(gbase) + (voff)[_i]), (LAS unsigned*)(lds + (bufoff) + ldsw + _i * 8192), 16, 0, 0); } while (0)
#define PG8_LDA(dst, b, h) do { _Pragma("unroll") for (int m = 0; m < 4; ++m) _Pragma("unroll") for (int k = 0; k < 2; ++k) dst[m][k] = *(const LAS bf16x8*)(lds + PG8_SA(b, h) + aoff + m * 2048 + k * 1024); } while (0)
#define PG8_LDB(dst, b, h) do { _Pragma("unroll") for (int n = 0; n < 2; ++n) _Pragma("unroll") for (int k = 0; k < 2; ++k) dst[n][k] = *(const LAS bf16x8*)(lds + PG8_SB(b, h) + boff + n * 2048 + k * 1024); } while (0)
#define PG8_MMA(ai, bj, At, Bt) do { __builtin_amdgcn_s_setprio(1); _Pragma("unroll") for (int m = 0; m < 4; ++m) _Pragma("unroll") for (int n = 0; n < 2; ++n) _Pragma("unroll") for (int k = 0; k < 2; ++k) \
        acc[ai][bj][m][n] = __builtin_amdgcn_mfma_f32_16x16x32_bf16(Bt[n][k], At[m][k], acc[ai][bj][m][n], 0, 0, 0); __builtin_amdgcn_s_setprio(0); } while (0)
#define PG8_WAIT_V(n) asm volatile("s_waitcnt vmcnt(" #n ")" ::: "memory")
#define PG8_WAIT_L(n) asm volatile("s_waitcnt lgkmcnt(" #n ")" ::: "memory")
#define PG8_BAR __builtin_amdgcn_s_barrier()
#define PG8_SCHED __builtin_amdgcn_sched_barrier(0)
    Unit cur, nxt; int ui = 0;
    if (!S.next(0, cur)) return;
    f32x4 acc[2][2][4][2];
#pragma unroll
    for (int a = 0; a < 2; ++a)
#pragma unroll
        for (int b = 0; b < 2; ++b)
#pragma unroll
            for (int m = 0; m < 4; ++m)
#pragma unroll
                for (int n = 0; n < 2; ++n) acc[a][b][m][n] = (f32x4){0.f, 0.f, 0.f, 0.f};
    bf16x8 At[4][2], B0[2][2], B1[2][2];
    const char* cA = Epi::swapped(cur) ? (const char*)g.Bt + (size_t)cur.pn * tstep : (const char*)g.A + (size_t)cur.pm * tstep;
    const char* cB = Epi::swapped(cur) ? (const char*)g.A + (size_t)cur.pm * tstep : (const char*)g.Bt + (size_t)cur.pn * tstep;
    PG8_STAGE(PG8_SB(0, 0), cB, voffB); PG8_STAGE(PG8_SA(0, 0), cA, voffA); PG8_STAGE(PG8_SB(0, 1), cB + hstep, voffB); PG8_STAGE(PG8_SA(0, 1), cA + hstep, voffA);
    if (wr == 1) PG8_BAR;
    PG8_WAIT_V(4); PG8_BAR;
    PG8_STAGE(PG8_SB(1, 0), cB + kstep, voffB); PG8_STAGE(PG8_SA(1, 0), cA + kstep, voffA); PG8_STAGE(PG8_SB(1, 1), cB + hstep + kstep, voffB);
    PG8_WAIT_V(6); PG8_BAR;
    for (;;) {
        const bool has_next = S.next(ui + 1, nxt);
        const bool nsw = has_next && Epi::swapped(nxt);
        const char* nA = has_next ? (nsw ? (const char*)g.Bt + (size_t)nxt.pn * tstep : (const char*)g.A + (size_t)nxt.pm * tstep) : cA;
        const char* nB = has_next ? (nsw ? (const char*)g.A + (size_t)nxt.pm * tstep : (const char*)g.Bt + (size_t)nxt.pn * tstep) : cB;
        for (int t = 0; t < nt; t += 2) {
            const bool last = (t == nt - 2);
            const char* a1 = cA + (size_t)(t + 1) * kstep;
            const char* a2 = last ? nA : cA + (size_t)(t + 2) * kstep; const char* b2 = last ? nB : cB + (size_t)(t + 2) * kstep;
            const char* a3 = a2 + kstep; const char* b3 = b2 + kstep;
            PG8_LDB(B0, 0, 0); PG8_SCHED; PG8_LDA(At, 0, 0); PG8_STAGE(PG8_SA(1, 1), a1 + hstep, voffA);
            PG8_WAIT_L(8); PG8_BAR; PG8_WAIT_L(0); PG8_MMA(0, 0, At, B0); PG8_BAR; PG8_SCHED;
            PG8_LDB(B1, 0, 1); PG8_STAGE(PG8_SB(0, 0), b2, voffB);
            PG8_BAR; PG8_WAIT_L(0); PG8_MMA(0, 1, At, B1); PG8_BAR;
            PG8_LDA(At, 0, 1); PG8_STAGE(PG8_SA(0, 0), a2, voffA);
            PG8_BAR; PG8_WAIT_L(0); PG8_MMA(1, 0, At, B0); PG8_BAR; PG8_SCHED;
            PG8_STAGE(PG8_SB(0, 1), b2 + hstep, voffB);
            PG8_WAIT_V(6); PG8_BAR; PG8_MMA(1, 1, At, B1); PG8_BAR;
            PG8_LDB(B0, 1, 0); PG8_SCHED; PG8_LDA(At, 1, 0); PG8_STAGE(PG8_SA(0, 1), a2 + hstep, voffA);
            PG8_WAIT_L(8); PG8_BAR; PG8_WAIT_L(0); PG8_MMA(0, 0, At, B0); PG8_BAR; PG8_SCHED;
            PG8_LDB(B1, 1, 1); PG8_STAGE(PG8_SB(1, 0), b3, voffB);
            PG8_BAR; PG8_WAIT_L(0); PG8_MMA(0, 1, At, B1); PG8_BAR;
            PG8_LDA(At, 1, 1); PG8_STAGE(PG8_SA(1, 0), a3, voffA);
            PG8_BAR; PG8_WAIT_L(0); PG8_MMA(1, 0, At, B0); PG8_BAR; PG8_SCHED;
            PG8_STAGE(PG8_SB(1, 1), b3 + hstep, voffB);
            PG8_WAIT_V(6); PG8_BAR; PG8_MMA(1, 1, At, B1); PG8_BAR;
        }
        E(acc, cur, wr, wc, fr, fq);
        if (!has_next) break;
#pragma unroll
        for (int a = 0; a < 2; ++a)
#pragma unroll
            for (int b = 0; b < 2; ++b)
#pragma unroll
                for (int m = 0; m < 4; ++m)
#pragma unroll
                    for (int n = 0; n < 2; ++n) acc[a][b][m][n] = (f32x4){0.f, 0.f, 0.f, 0.f};
        cur = nxt; cA = nA; cB = nB; ++ui;
    }
    PG8_WAIT_V(0);
    if (wr == 0) PG8_BAR;
    PG8_BAR;
#undef PG8_SA
#undef PG8_SB
#undef PG8_STAGE
#undef PG8_LDA
#undef PG8_LDB
#undef PG8_MMA
#undef PG8_WAIT_V
#undef PG8_WAIT_L
#undef PG8_BAR
#undef PG8_SCHED
}
struct PanelOrder {
    int panel, nN;
    __device__ bool next(int i, Unit& u) const { if (i >= nN) return false; u.pm = panel; u.pn = i; return true; }
};
}
using pg8::Unit;
typedef f32x4 AccT[2][2][4][2];

struct Epi1 {
    unsigned char* ws; int row_base;
    static __device__ __forceinline__ bool swapped(const Unit& u) { const int grp = u.pn >> 1; return grp == 2 || grp == 7; }
    template <int GRP> __device__ __forceinline__ void run(const AccT& acc, const Unit& u, int wr, int wc, int fr, int fq) const {
        if constexpr (GRP == 2 || GRP == 7) {
            const int t00 = row_base + u.pm * 256 + wc * 32 + 8 * fq;
            const int b = t00 >> 12;
#pragma unroll
            for (int ai = 0; ai < 2; ++ai)
#pragma unroll
                for (int m = 0; m < 4; ++m) {
                    const int col = (u.pn & 1) * 256 + ai * 128 + wr * 64 + m * 16 + fr;
#pragma unroll
                    for (int bj = 0; bj < 2; ++bj) {
                        const int s = (t00 + bj * 128) & 4095;
                        float v[8];
#pragma unroll
                        for (int e = 0; e < 4; ++e) { v[e] = acc[ai][bj][m][0][e]; v[4 + e] = acc[ai][bj][m][1][e]; }
                        u32x4 w; w.x = pk2(v[0], v[1]); w.y = pk2(v[2], v[3]); w.z = pk2(v[4], v[5]); w.w = pk2(v[6], v[7]);
                        if constexpr (GRP == 2)
                            *(u32x4*)((bf16_t*)(ws + OFF_VT) + ((size_t)((b * 8 + (col >> 6)) * 64 + (s >> 6)) * 64 + (col & 63)) * 64 + (s & 63)) = w;
                        else
                            *(u32x4*)((bf16_t*)(ws + OFF_HIT) + ((size_t)(b * 512 + col)) * 4096 + s) = w;
                    }
                }
            return;
        }
        const int colg0 = (u.pn & 1) * 256 + wc * 32 + 8 * fq;
        const int row0 = row_base + u.pm * 256 + wr * 64 + fr;
        float lbv[16];
        if constexpr (GRP == 5 || GRP == 6) {
            const float* lb = (const float*)(ws + OFF_LB) + (GRP - 5) * 512 + colg0;
#pragma unroll
            for (int bj = 0; bj < 2; ++bj) {
                const f32x4 a = *(const f32x4*)(lb + bj * 128), b = *(const f32x4*)(lb + bj * 128 + 4);
#pragma unroll
                for (int e = 0; e < 4; ++e) { lbv[bj * 8 + e] = a[e]; lbv[bj * 8 + 4 + e] = b[e]; }
            }
        }
#pragma unroll
        for (int ai = 0; ai < 2; ++ai)
#pragma unroll
            for (int m = 0; m < 4; ++m) {
                const int row = row0 + ai * 128 + m * 16;
                const int b = row >> 12, s = row & 4095;
#pragma unroll
                for (int bj = 0; bj < 2; ++bj) {
                    const int col = colg0 + bj * 128;
                    float v[8];
#pragma unroll
                    for (int e = 0; e < 4; ++e) { v[e] = acc[ai][bj][m][0][e]; v[4 + e] = acc[ai][bj][m][1][e]; }
                    if constexpr (GRP == 7) {
                        bf16_t* base = (bf16_t*)(ws + OFF_HIT) + ((size_t)(b * 512 + col)) * 4096 + s;
#pragma unroll
                        for (int e = 0; e < 8; ++e) base[(size_t)e * 4096] = (bf16_t)(pk2(v[e], 0.f) & 0xffffu);
                    } else if constexpr (GRP == 2) {
                        bf16_t* base = (bf16_t*)(ws + OFF_VT) + ((size_t)((b * 8 + (col >> 6)) * 64 + (s >> 6)) * 64 + (col & 63)) * 64 + (s & 63);
#pragma unroll
                        for (int e = 0; e < 8; ++e) base[e * 64] = (bf16_t)(pk2(v[e], 0.f) & 0xffffu);
                    } else if constexpr (GRP <= 1) {
                        if constexpr (GRP == 0) {
#pragma unroll
                            for (int e = 0; e < 8; ++e) v[e] *= 0.18033688011112042f;
                        }
                        u32x4 w; w.x = pk2(v[0], v[1]); w.y = pk2(v[2], v[3]); w.z = pk2(v[4], v[5]); w.w = pk2(v[6], v[7]);
                        *(u32x4*)((bf16_t*)(ws + (GRP == 0 ? OFF_Q : OFF_K)) + ((size_t)(b * 8 + (col >> 6)) * 4096 + s) * 64 + (col & 63)) = w;
                    } else {
                        if constexpr (GRP == 3 || GRP == 8) {
                        } else if constexpr (GRP == 4) {
#pragma unroll
                            for (int e = 0; e < 8; ++e) v[e] = siluf_(v[e]);
                        } else {
#pragma unroll
                            for (int e = 0; e < 8; ++e) { const float l = lbv[bj * 8 + e]; v[e] = __builtin_amdgcn_logf(l + (1.0f - l) * sigmoidf_(v[e]));   }
                        }
                        constexpr size_t off = GRP == 3 ? OFF_SG : GRP == 4 ? OFF_HQ : GRP == 5 ? OFF_GF : GRP == 6 ? OFF_GF + 64 * MiB : OFF_SHG;
                        u32x4 w; w.x = pk2(v[0], v[1]); w.y = pk2(v[2], v[3]); w.z = pk2(v[4], v[5]); w.w = pk2(v[6], v[7]);
                        *(u32x4*)((bf16_t*)(ws + off) + (size_t)row * 512 + col) = w;
                    }
                }
            }
    }
    __device__ __forceinline__ void operator()(const AccT& acc, const Unit& u, int wr, int wc, int fr, int fq) const {
        asm volatile("" : "+v"(fr), "+v"(fq));
        switch (u.pn >> 1) {
            case 0: run<0>(acc, u, wr, wc, fr, fq); break; case 1: run<1>(acc, u, wr, wc, fr, fq); break; case 2: run<2>(acc, u, wr, wc, fr, fq); break;
            case 3: run<3>(acc, u, wr, wc, fr, fq); break; case 4: run<4>(acc, u, wr, wc, fr, fq); break; case 5: run<5>(acc, u, wr, wc, fr, fq); break;
            case 6: run<6>(acc, u, wr, wc, fr, fq); break; case 7: run<7>(acc, u, wr, wc, fr, fq); break; default: run<8>(acc, u, wr, wc, fr, fq); break;
        }
    }
};
struct EpiPP {
    static __device__ __forceinline__ bool swapped(const Unit&) { return false; }
    bf16_t* O;
    __device__ __forceinline__ void operator()(const AccT& acc, const Unit& u, int wr, int wc, int fr, int fq) const {
        asm volatile("" : "+v"(fr), "+v"(fq));
        const int row0 = u.pm * 256 + wr * 64 + fr, col0 = u.pn * 256 + wc * 32 + 8 * fq;
#pragma unroll
        for (int ai = 0; ai < 2; ++ai)
#pragma unroll
            for (int m = 0; m < 4; ++m)
#pragma unroll
                for (int bj = 0; bj < 2; ++bj) {
                    const f32x4 v0 = acc[ai][bj][m][0], v1 = acc[ai][bj][m][1];
                    u32x4 w; w.x = pk2(v0[0], v0[1]); w.y = pk2(v0[2], v0[3]); w.z = pk2(v1[0], v1[1]); w.w = pk2(v1[2], v1[3]);
                    *(u32x4*)(O + (size_t)(row0 + ai * 128 + m * 16) * 1024 + col0 + bj * 128) = w;
                }
    }
};
struct Epi2 {
    static __device__ __forceinline__ bool swapped(const Unit&) { return false; }
    const float* x; float* out; bf16_t* hb; float* ss;
    __device__ __forceinline__ void operator()(const AccT& acc, const Unit& u, int wr, int wc, int fr, int fq) const {
        asm volatile("" : "+v"(fr), "+v"(fq));
        const int row0 = u.pm * 256 + wr * 64 + fr, col0 = u.pn * 256 + wc * 32 + 8 * fq;
#pragma unroll
        for (int ai = 0; ai < 2; ++ai) {
            f32x4 xv[4][2][2];
#pragma unroll
            for (int m = 0; m < 4; ++m)
#pragma unroll
                for (int bj = 0; bj < 2; ++bj) {
                    const size_t o = (size_t)(row0 + ai * 128 + m * 16) * 1024 + col0 + bj * 128;
                    xv[m][bj][0] = *(const f32x4*)(x + o); xv[m][bj][1] = *(const f32x4*)(x + o + 4);
                }
#pragma unroll
            for (int m = 0; m < 4; ++m) {
                const int row = row0 + ai * 128 + m * 16;
                float s2 = 0.f;
#pragma unroll
                for (int bj = 0; bj < 2; ++bj) {
                    const size_t o = (size_t)row * 1024 + col0 + bj * 128;
                    const f32x4 h0 = xv[m][bj][0] + acc[ai][bj][m][0], h1 = xv[m][bj][1] + acc[ai][bj][m][1];
                    *(f32x4*)(out + o) = h0; *(f32x4*)(out + o + 4) = h1;
                    u32x4 w; w.x = pk2(h0[0], h0[1]); w.y = pk2(h0[2], h0[3]); w.z = pk2(h1[0], h1[1]); w.w = pk2(h1[2], h1[3]);
                    *(u32x4*)(hb + o) = w;
                    s2 += h0[0] * h0[0] + h0[1] * h0[1] + h0[2] * h0[2] + h0[3] * h0[3] + h1[0] * h1[0] + h1[1] * h1[1] + h1[2] * h1[2] + h1[3] * h1[3];
                }
                s2 += __shfl_xor(s2, 16); s2 += __shfl_xor(s2, 32);
                if (fq == 0) atomicAdd(ss + row, s2);
            }
        }
    }
};
struct Epi3 {
    static __device__ __forceinline__ bool swapped(const Unit&) { return false; }
    float* out; const bf16_t* pp; const float* ss2; float* ss3;
    __device__ __forceinline__ void operator()(const AccT& acc, const Unit& u, int wr, int wc, int fr, int fq) const {
        asm volatile("" : "+v"(fr), "+v"(fq));
        const int row0 = u.pm * 256 + wr * 64 + fr, col0 = u.pn * 256 + wc * 32 + 8 * fq;
        float rsv[8];
#pragma unroll
        for (int i = 0; i < 8; ++i) rsv[i] = ss2[row0 + (i >> 2) * 128 + (i & 3) * 16];
#pragma unroll
        for (int ai = 0; ai < 2; ++ai)
#pragma unroll
            for (int mh = 0; mh < 2; ++mh) {
                f32x4 hv[2][2][2]; u32x4 pw[2][2];
#pragma unroll
                for (int mm = 0; mm < 2; ++mm)
#pragma unroll
                    for (int bj = 0; bj < 2; ++bj) {
                        const size_t o = (size_t)(row0 + ai * 128 + (mh * 2 + mm) * 16) * 1024 + col0 + bj * 128;
                        hv[mm][bj][0] = *(const f32x4*)(out + o); hv[mm][bj][1] = *(const f32x4*)(out + o + 4); pw[mm][bj] = *(const u32x4*)(pp + o);
                    }
#pragma unroll
                for (int mm = 0; mm < 2; ++mm) {
                    const int m = mh * 2 + mm, row = row0 + ai * 128 + m * 16;
                    const float rs = rsqrtf(rsv[ai * 4 + m] * (1.0f / 1024.0f) + EPS);
                    float s2 = 0.f;
#pragma unroll
                    for (int bj = 0; bj < 2; ++bj) {
                        const size_t o = (size_t)row * 1024 + col0 + bj * 128;
                        const u32x4 q = pw[mm][bj];
                        const float pv[8] = {bf_lo(q.x), bf_hi(q.x), bf_lo(q.y), bf_hi(q.y), bf_lo(q.z), bf_hi(q.z), bf_lo(q.w), bf_hi(q.w)};
                        f32x4 r0, r1;
#pragma unroll
                        for (int e = 0; e < 4; ++e) {
                            r0[e] = hv[mm][bj][0][e] + sigmoidf_(acc[ai][bj][m][0][e] * rs) * pv[e];
                            r1[e] = hv[mm][bj][1][e] + sigmoidf_(acc[ai][bj][m][1][e] * rs) * pv[4 + e];
                            s2 += r0[e] * r0[e] + r1[e] * r1[e];
                        }
                        *(f32x4*)(out + o) = r0; *(f32x4*)(out + o + 4) = r1;
                    }
                    s2 += __shfl_xor(s2, 16); s2 += __shfl_xor(s2, 32);
                    if (fq == 0) atomicAdd(ss3 + row, s2);
                }
            }
    }
};

struct Epi2P {
    static __device__ __forceinline__ bool swapped(const Unit&) { return false; }
    const float* x; float* out; bf16_t* hb; LAS float* ssl;
    __device__ __forceinline__ void operator()(const AccT& acc, const Unit& u, int wr, int wc, int fr, int fq) const {
        asm volatile("" : "+v"(fr), "+v"(fq));
        const int lrow0 = wr * 64 + fr, row0 = u.pm * 256 + lrow0, col0 = u.pn * 256 + wc * 32 + 8 * fq;
#pragma unroll
        for (int ai = 0; ai < 2; ++ai) {
            f32x4 xv[4][2][2];
#pragma unroll
            for (int m = 0; m < 4; ++m)
#pragma unroll
                for (int bj = 0; bj < 2; ++bj) {
                    const size_t o = (size_t)(row0 + ai * 128 + m * 16) * 1024 + col0 + bj * 128;
                    xv[m][bj][0] = *(const f32x4*)(x + o); xv[m][bj][1] = *(const f32x4*)(x + o + 4);
                }
#pragma unroll
            for (int m = 0; m < 4; ++m) {
                const int row = row0 + ai * 128 + m * 16;
                float s2 = 0.f;
#pragma unroll
                for (int bj = 0; bj < 2; ++bj) {
                    const size_t o = (size_t)row * 1024 + col0 + bj * 128;
                    const f32x4 h0 = xv[m][bj][0] + acc[ai][bj][m][0], h1 = xv[m][bj][1] + acc[ai][bj][m][1];
                    u32x4 w; w.x = pk2(h0[0], h0[1]); w.y = pk2(h0[2], h0[3]); w.z = pk2(h1[0], h1[1]); w.w = pk2(h1[2], h1[3]);
                    *(u32x4*)(hb + o) = w;
                    s2 += h0[0] * h0[0] + h0[1] * h0[1] + h0[2] * h0[2] + h0[3] * h0[3] + h1[0] * h1[0] + h1[1] * h1[1] + h1[2] * h1[2] + h1[3] * h1[3];
                }
                s2 += __shfl_xor(s2, 16); s2 += __shfl_xor(s2, 32);
                if (fq == 0) __hip_atomic_fetch_add(ssl + lrow0 + ai * 128 + m * 16, s2, __ATOMIC_RELAXED, __HIP_MEMORY_SCOPE_WORKGROUP);
            }
        }
    }
};
struct Epi3P {
    static __device__ __forceinline__ bool swapped(const Unit&) { return false; }
    bf16_t* hfb; const bf16_t* pp; const bf16_t* hb; const LAS float* ss2l; LAS float* ss3l;
    __device__ __forceinline__ void operator()(const AccT& acc, const Unit& u, int wr, int wc, int fr, int fq) const {
        asm volatile("" : "+v"(fr), "+v"(fq));
        const int lrow0 = wr * 64 + fr, row0 = u.pm * 256 + lrow0, col0 = u.pn * 256 + wc * 32 + 8 * fq;
#pragma unroll
        for (int ai = 0; ai < 2; ++ai) {
            u32x4 hw[4][2], pw[4][2];
#pragma unroll
            for (int m = 0; m < 4; ++m)
#pragma unroll
                for (int bj = 0; bj < 2; ++bj) {
                    const size_t o = (size_t)(row0 + ai * 128 + m * 16) * 1024 + col0 + bj * 128;
                    hw[m][bj] = *(const u32x4*)(hb + o); pw[m][bj] = *(const u32x4*)(pp + o);
                }
#pragma unroll
            for (int m = 0; m < 4; ++m) {
                const int lrow = lrow0 + ai * 128 + m * 16, row = u.pm * 256 + lrow;
                const float rs = rsqrtf(ss2l[lrow] * (1.0f / 1024.0f) + EPS);
                float s2 = 0.f;
#pragma unroll
                for (int bj = 0; bj < 2; ++bj) {
                    const size_t o = (size_t)row * 1024 + col0 + bj * 128;
                    const u32x4 q = pw[m][bj], hq = hw[m][bj];
                    const float pv[8] = {bf_lo(q.x), bf_hi(q.x), bf_lo(q.y), bf_hi(q.y), bf_lo(q.z), bf_hi(q.z), bf_lo(q.w), bf_hi(q.w)};
                    const float hv[8] = {bf_lo(hq.x), bf_hi(hq.x), bf_lo(hq.y), bf_hi(hq.y), bf_lo(hq.z), bf_hi(hq.z), bf_lo(hq.w), bf_hi(hq.w)};
                    f32x4 r0, r1;
#pragma unroll
                    for (int e = 0; e < 4; ++e) {
                        r0[e] = hv[e] + sigmoidf_(acc[ai][bj][m][0][e] * rs) * pv[e];
                        r1[e] = hv[4 + e] + sigmoidf_(acc[ai][bj][m][1][e] * rs) * pv[4 + e];
                        s2 += r0[e] * r0[e] + r1[e] * r1[e];
                    }
                    u32x4 w; w.x = pk2(r0[0], r0[1]); w.y = pk2(r0[2], r0[3]); w.z = pk2(r1[0], r1[1]); w.w = pk2(r1[2], r1[3]);
                    *(u32x4*)(hfb + o) = w;
                }
                s2 += __shfl_xor(s2, 16); s2 += __shfl_xor(s2, 32);
                if (fq == 0) __hip_atomic_fetch_add(ss3l + lrow, s2, __ATOMIC_RELAXED, __HIP_MEMORY_SCOPE_WORKGROUP);
            }
        }
    }
};

__device__ __forceinline__ void transpose_w(const float* W, const float* scale, bf16_t* WT, int K, int N, int gt, int NT) {
    const int total = N * (K / 8);
    for (int idx = gt; idx < total; idx += NT) {
        const int n = idx % N, k0 = (idx / N) * 8;
        float v[8];
#pragma unroll
        for (int j = 0; j < 8; ++j) { v[j] = W[(size_t)(k0 + j) * N + n]; if (scale) v[j] *= scale[k0 + j]; }
        u32x4 w; w.x = pk2(v[0], v[1]); w.y = pk2(v[2], v[3]); w.z = pk2(v[4], v[5]); w.w = pk2(v[6], v[7]);
        *(u32x4*)(WT + (size_t)n * K + k0) = w;
    }
}
__device__ __forceinline__ void convert_x_rows(const Params& P, int r0, int n, int wv, int nw, int lane) {
    bf16_t* xb = (bf16_t*)(P.ws + OFF_XB);
    for (int row = r0 + wv; row < r0 + n; row += 2 * nw) {
        const int row2 = row + nw;
        const f32x4* xr = (const f32x4*)(P.x + (size_t)row * 1024) + lane;
        const f32x4* xr2 = (const f32x4*)(P.x + (size_t)row2 * 1024) + lane;
        f32x4 v[4], v2[4]; float s = 0.f, s2 = 0.f;
#pragma unroll
        for (int j = 0; j < 4; ++j) { v[j] = xr[64 * j]; v2[j] = xr2[64 * j]; }
#pragma unroll
        for (int j = 0; j < 4; ++j) { s += v[j][0] * v[j][0] + v[j][1] * v[j][1] + v[j][2] * v[j][2] + v[j][3] * v[j][3];
                                      s2 += v2[j][0] * v2[j][0] + v2[j][1] * v2[j][1] + v2[j][2] * v2[j][2] + v2[j][3] * v2[j][3]; }
        s = wave_sum(s); s2 = wave_sum(s2);
        const float rs = rsqrtf(s * (1.0f / 1024.0f) + EPS), rs2 = rsqrtf(s2 * (1.0f / 1024.0f) + EPS);
        u32x2* o = (u32x2*)(xb + (size_t)row * 1024) + lane;
        u32x2* o2 = (u32x2*)(xb + (size_t)row2 * 1024) + lane;
#pragma unroll
        for (int j = 0; j < 4; ++j) { u32x2 w; w.x = pk2(v[j][0] * rs, v[j][1] * rs); w.y = pk2(v[j][2] * rs, v[j][3] * rs); o[64 * j] = w;
                                      u32x2 w2; w2.x = pk2(v2[j][0] * rs2, v2[j][1] * rs2); w2.y = pk2(v2[j][2] * rs2, v2[j][3] * rs2); o2[64 * j] = w2; }
    }
}
__device__ __forceinline__ void phase_prep(const Params& P) {
    const int tid = threadIdx.x, wave = tid >> 6, lane = tid & 63;
    const int gw = blockIdx.x * 8 + wave, NGW = gridDim.x * 8;
    const int gt = blockIdx.x * 512 + tid, NT = gridDim.x * 512;
    unsigned char* ws = P.ws;
    convert_x_rows(P, 0, NTOK / 2, gw, NGW, lane);
    bf16_t* pb = (bf16_t*)(ws + OFF_PB);
    for (int row = gw; row < NTOK; row += NGW) {
        const f32x4 v = ((const f32x4*)(P.p + (size_t)row * 256))[lane];
        u32x2 w; w.x = pk2(v[0], v[1]); w.y = pk2(v[2], v[3]);
        ((u32x2*)(pb + (size_t)row * 256))[lane] = w;
    }
    transpose_w(P.w_in, P.ln_mix, (bf16_t*)(ws + OFF_W1T), 1024, 4608, gt, NT);
    transpose_w(P.w_out, nullptr, (bf16_t*)(ws + OFF_W2T), 1024, 1024, gt, NT);
    transpose_w(P.w_pg, P.ln_ple, (bf16_t*)(ws + OFF_W3T), 1024, 1024, gt, NT);
    transpose_w(P.w_pp, nullptr, (bf16_t*)(ws + OFF_W4T), 256, 1024, gt, NT);
    float* lb = (float*)(ws + OFF_LB);
    for (int i = gt; i < 1024; i += NT) lb[i] = sigmoidf_(P.lb_logits[i] - P.lb_logits[1024 + i]);
}

constexpr int HS_LD = 136, HS_LD64 = 72;
constexpr int L_QT = 0, L_QH = 17408, L_KH = 34816, L_KT = 52224, L_VTT = 70656, L_P = 79872, L_ST = 89088, L_SEG = 106496, L_ETOT = 110592;
#define MFMA32(a, b, c) __builtin_amdgcn_mfma_f32_32x32x16_bf16((a), (b), (c), 0, 0, 0)
#define MFMA16(a, b, c) __builtin_amdgcn_mfma_f32_16x16x32_bf16((a), (b), (c), 0, 0, 0)

__device__ __forceinline__ void hgrn_scan_task(const Params& P, LAS unsigned char* lds, int task) {
    const int tid = threadIdx.x, w = __builtin_amdgcn_readfirstlane(tid >> 6), lane = tid & 63;
    const int half = task & 1, h = (task >> 1) & 3, b = (task >> 3) & 15, dir = task >> 7;
    LAS unsigned* QT32 = (LAS unsigned*)(lds + L_QT); LAS unsigned* QH32 = (LAS unsigned*)(lds + L_QH); LAS unsigned* KH32 = (LAS unsigned*)(lds + L_KH);
    LAS bf16_t* QT = (LAS bf16_t*)(lds + L_QT); LAS bf16_t* QH = (LAS bf16_t*)(lds + L_QH); LAS bf16_t* KH = (LAS bf16_t*)(lds + L_KH);
    LAS bf16_t* KT = (LAS bf16_t*)(lds + L_KT); LAS bf16_t* VTT = (LAS bf16_t*)(lds + L_VTT); LAS bf16_t* PL = (LAS bf16_t*)(lds + L_P);
    LAS bf16_t* ST = (LAS bf16_t*)(lds + L_ST); LAS float* SEG = (LAS float*)(lds + L_SEG); LAS float* ETOT = (LAS float*)(lds + L_ETOT);
    const bf16_t* G = (const bf16_t*)(P.ws + OFF_GF + (size_t)dir * 64 * MiB);
    const bf16_t* HQ = (const bf16_t*)(P.ws + OFF_HQ);
    const bf16_t* HIT = (const bf16_t*)(P.ws + OFF_HIT);
    bf16_t* OD = (bf16_t*)(P.ws + OFF_OD + (size_t)dir * 64 * MiB);
    for (int i = tid; i < 64 * HS_LD / 2; i += 512) ((LAS unsigned*)ST)[i] = 0u;
    f32x16 sacc;
#pragma unroll
    for (int i = 0; i < 16; ++i) sacc[i] = 0.f;
    const size_t tokbase = (size_t)b * 4096;
    const int r = lane & 31, hh = lane >> 5;
    const char* g_u = (const char*)G + (tokbase + 8 * w) * 1024 + h * 256;
    const char* q_u = (const char*)HQ + (tokbase + 8 * w) * 1024 + h * 256;
    const char* v_u = (const char*)HIT + ((size_t)((b * 4 + h) * 128 + half * 64)) * 8192;
    const unsigned gq_off = 4u * lane, v_off = (unsigned)(tid >> 3) * 8192u + (unsigned)(tid & 7) * 16u;
    unsigned gr[8], qr[8]; u32x4 vr;
#define HS_LOAD(c) do { const char* gc_ = g_u + (size_t)(c) * 65536; const char* qc_ = q_u + (size_t)(c) * 65536; \
        _Pragma("unroll") for (int i = 0; i < 8; ++i) { gr[i] = *(const unsigned*)(gc_ + i * 1024 + gq_off); qr[i] = *(const unsigned*)(qc_ + i * 1024 + gq_off); } \
        vr = *(const u32x4*)(v_u + (size_t)(c) * 128 + v_off); } while (0)
    { const int c0 = dir ? 63 : 0; HS_LOAD(c0); }
    for (int ci = 0; ci < 64; ++ci) {
        const int c = dir ? 63 - ci : ci;
        float g0[8], g1[8], bl0[8], bl1[8];
#pragma unroll
        for (int i = 0; i < 8; ++i) { g0[i] = bf_lo(gr[i]); g1[i] = bf_hi(gr[i]); }
        float a0 = 0.f, a1 = 0.f;
        if (dir == 0) {
#pragma unroll
            for (int i = 0; i < 8; ++i) { a0 += g0[i]; a1 += g1[i]; bl0[i] = a0; bl1[i] = a1; }
        } else {
#pragma unroll
            for (int i = 7; i >= 0; --i) { a0 += g0[i]; a1 += g1[i]; bl0[i] = a0; bl1[i] = a1; }
        }
        *(LAS f32x2*)(SEG + w * 128 + 2 * lane) = (f32x2){a0, a1};
        LDS_BAR();
        float off0 = 0.f, off1 = 0.f, ref0 = 0.f, ref1 = 0.f, tot0 = 0.f, tot1 = 0.f;
#pragma unroll
        for (int w2 = 0; w2 < 8; ++w2) {
            const f32x2 sv = *(const LAS f32x2*)(SEG + w2 * 128 + 2 * lane);
            tot0 += sv[0]; tot1 += sv[1];
            const bool before = dir == 0 ? (w2 < w) : (w2 > w);
            const bool inref = dir == 0 ? (w2 < 4) : (w2 >= 4);
            if (before) { off0 += sv[0]; off1 += sv[1]; }
            if (inref) { ref0 += sv[0]; ref1 += sv[1]; }
        }
        float kta[8], ktb[8];
        const float er0 = __builtin_amdgcn_exp2f(ref0), er1 = __builtin_amdgcn_exp2f(ref1), et0 = __builtin_amdgcn_exp2f(tot0 - ref0), et1 = __builtin_amdgcn_exp2f(tot1 - ref1);
#pragma unroll
        for (int i = 0; i < 8; ++i) {
            const int t = 8 * w + i;
            const float b0 = off0 + bl0[i], b1 = off1 + bl1[i];
            const float q0 = bf_lo(qr[i]), q1 = bf_hi(qr[i]);
            const float k0 = 1.0f - __builtin_amdgcn_exp2f(g0[i]), k1 = 1.0f - __builtin_amdgcn_exp2f(g1[i]);
            const float qh0 = q0 * __builtin_amdgcn_exp2f(fminf(b0 - ref0, 115.f)), qh1 = q1 * __builtin_amdgcn_exp2f(fminf(b1 - ref1, 115.f));
            const float kh0 = k0 * __builtin_amdgcn_exp2f(fminf(ref0 - b0, 115.f)), kh1 = k1 * __builtin_amdgcn_exp2f(fminf(ref1 - b1, 115.f));
            QT32[t * (HS_LD / 2) + lane] = pk2(qh0 * er0, qh1 * er1);
            QH32[t * (HS_LD / 2) + lane] = pk2(qh0, qh1);
            KH32[t * (HS_LD / 2) + lane] = pk2(kh0, kh1);
            kta[i] = kh0 * et0; ktb[i] = kh1 * et1;
        }
        { u32x4 wa, wb; wa.x = pk2(kta[0], kta[1]); wa.y = pk2(kta[2], kta[3]); wa.z = pk2(kta[4], kta[5]); wa.w = pk2(kta[6], kta[7]);
          wb.x = pk2(ktb[0], ktb[1]); wb.y = pk2(ktb[2], ktb[3]); wb.z = pk2(ktb[4], ktb[5]); wb.w = pk2(ktb[6], ktb[7]);
          *(LAS u32x4*)(KT + (2 * lane) * HS_LD64 + 8 * w) = wa; *(LAS u32x4*)(KT + (2 * lane + 1) * HS_LD64 + 8 * w) = wb; }
        *(LAS u32x4*)(VTT + (tid >> 3) * HS_LD64 + (tid & 7) * 8) = vr;
        if (w == 0) { *(LAS f32x2*)(ETOT + 2 * lane) = (f32x2){__builtin_amdgcn_exp2f(tot0), __builtin_amdgcn_exp2f(tot1)}; }
        LDS_BAR();
        if (ci + 1 < 64) { const int cn = dir ? 62 - ci : ci + 1; HS_LOAD(cn); }
        f32x16 o;
#pragma unroll
        for (int i = 0; i < 16; ++i) o[i] = 0.f;
        const int ti = (w >> 1) & 1, di = w & 1;
        if (w < 4) {
            const int si = w >> 1, tj = w & 1;
            f32x16 sc;
#pragma unroll
            for (int i = 0; i < 16; ++i) sc[i] = 0.f;
#pragma unroll
            for (int ks = 0; ks < 8; ++ks) {
                const bf16x8 a = *(const LAS bf16x8*)(KH + (32 * si + r) * HS_LD + 16 * ks + 8 * hh);
                const bf16x8 bq = *(const LAS bf16x8*)(QH + (32 * tj + r) * HS_LD + 16 * ks + 8 * hh);
                sc = MFMA32(a, bq, sc);
            }
            const int t = 32 * tj + r;
#pragma unroll
            for (int q4 = 0; q4 < 4; ++q4) {
                const int s0 = 32 * si + 8 * q4 + 4 * hh;
                float pv[4];
#pragma unroll
                for (int e = 0; e < 4; ++e) { const int s = s0 + e; const bool keep = dir == 0 ? (s <= t) : (s >= t); pv[e] = keep ? sc[4 * q4 + e] : 0.f; }
                u32x2 wv; wv.x = pk2(pv[0], pv[1]); wv.y = pk2(pv[2], pv[3]);
                *(LAS u32x2*)(PL + t * HS_LD64 + s0) = wv;
            }
        } else {
#pragma unroll
            for (int ks = 0; ks < 8; ++ks) {
                const bf16x8 a = *(const LAS bf16x8*)(QT + (32 * ti + r) * HS_LD + 16 * ks + 8 * hh);
                const bf16x8 bs = *(const LAS bf16x8*)(ST + (32 * di + r) * HS_LD + 16 * ks + 8 * hh);
                o = MFMA32(a, bs, o);
            }
        }
        LDS_BAR();
        if (w >= 4) {
#pragma unroll
            for (int ks = 0; ks < 4; ++ks) {
                const bf16x8 a = *(const LAS bf16x8*)(PL + (32 * ti + r) * HS_LD64 + 16 * ks + 8 * hh);
                const bf16x8 bv = *(const LAS bf16x8*)(VTT + (32 * di + r) * HS_LD64 + 16 * ks + 8 * hh);
                o = MFMA32(a, bv, o);
            }
            char* o_u = (char*)OD + (tokbase + 64 * c + 32 * ti) * 1024 + (h * 128 + half * 64 + 32 * di) * 2;
            const unsigned o_off = (unsigned)hh * 4096u + 2u * (unsigned)r;
#pragma unroll
            for (int i = 0; i < 16; ++i) { const int tr = (i & 3) + 8 * (i >> 2); *(bf16_t*)(o_u + tr * 1024 + o_off) = (bf16_t)(pk2(o[i], 0.f) & 0xffffu); }
        }
        {
            const int ki = w >> 1, dj = w & 1;
#pragma unroll
            for (int q4 = 0; q4 < 4; ++q4) {
                const f32x4 et = *(const LAS f32x4*)(ETOT + 32 * ki + 8 * q4 + 4 * hh);
#pragma unroll
                for (int e = 0; e < 4; ++e) sacc[4 * q4 + e] *= et[e];
            }
#pragma unroll
            for (int ks = 0; ks < 4; ++ks) {
                const bf16x8 a = *(const LAS bf16x8*)(KT + (32 * ki + r) * HS_LD64 + 16 * ks + 8 * hh);
                const bf16x8 bv = *(const LAS bf16x8*)(VTT + (32 * dj + r) * HS_LD64 + 16 * ks + 8 * hh);
                sacc = MFMA32(a, bv, sacc);
            }
#pragma unroll
            for (int q4 = 0; q4 < 4; ++q4) {
                u32x2 wv; wv.x = pk2(sacc[4 * q4], sacc[4 * q4 + 1]); wv.y = pk2(sacc[4 * q4 + 2], sacc[4 * q4 + 3]);
                *(LAS u32x2*)(ST + (32 * dj + r) * HS_LD + 32 * ki + 8 * q4 + 4 * hh) = wv;
            }
        }
    }
    LDS_BAR();
#undef HS_LOAD
}

constexpr int S2_LD = 136, S2_LDC = 40;
constexpr int S2_BUF = 41984, S2_QT = 0, S2_QH = 8704, S2_KH = 17408, S2_KT = 26112, S2_VT = 36352;
constexpr int S2_ETOT = 83968, S2_P = 84992, S2_ST = 87552, S2_SEG = 104960;
template <int DIR>
__device__ __forceinline__ void hgrn_scan2(const Params& P, LAS unsigned char* lds, int task) {
    const int tid = threadIdx.x, w = __builtin_amdgcn_readfirstlane(tid >> 6), lane = tid & 63;
    const int half = task & 1, h = (task >> 1) & 3, b = (task >> 3) & 15;
    const bf16_t* G = (const bf16_t*)(P.ws + OFF_GF + (size_t)DIR * 64 * MiB);
    const bf16_t* HQ = (const bf16_t*)(P.ws + OFF_HQ);
    const bf16_t* HIT = (const bf16_t*)(P.ws + OFF_HIT);
    bf16_t* OD = (bf16_t*)(P.ws + OFF_OD + (size_t)DIR * 64 * MiB);
    const size_t tokbase = (size_t)b * 4096;
    LAS bf16_t* ST = (LAS bf16_t*)(lds + S2_ST); LAS bf16_t* PL = (LAS bf16_t*)(lds + S2_P);
    LAS float* SEG = (LAS float*)(lds + S2_SEG);
    for (int i = tid; i < 64 * S2_LD / 2; i += 512) ((LAS unsigned*)ST)[i] = 0u;
    const int r = lane & 31, hh = lane >> 5;
    if (w < 4) {
        const char* g_u = (const char*)G + (tokbase + 8 * w) * 1024 + h * 256;
        const char* q_u = (const char*)HQ + (tokbase + 8 * w) * 1024 + h * 256;
        const char* v_u = (const char*)HIT + ((size_t)((b * 4 + h) * 128 + half * 64)) * 8192;
        const unsigned gq_off = 4u * lane, v_off = (unsigned)(tid >> 2) * 8192u + (unsigned)(tid & 3) * 16u;
        unsigned gA[8], qA[8], gB[8], qB[8]; u32x4 vA, vB;
#define S2_LOAD(gr, qr, vr, s_) do { const int c_ = DIR ? 127 - (s_) : (s_); const char* gc_ = g_u + (size_t)c_ * 32768; const char* qc_ = q_u + (size_t)c_ * 32768; \
        _Pragma("unroll") for (int i = 0; i < 8; ++i) { gr[i] = *(const unsigned*)(gc_ + i * 1024 + gq_off); qr[i] = *(const unsigned*)(qc_ + i * 1024 + gq_off); } \
        vr = *(const u32x4*)(v_u + (size_t)c_ * 64 + v_off); } while (0)
#define S2_PRODUCE(gr, qr, vr, s_) do { \
          \
        LAS unsigned char* bufp = lds + ((s_) & 1) * S2_BUF; \
        *(LAS u32x4*)((LAS bf16_t*)(bufp + S2_VT) + (tid >> 2) * S2_LDC + (tid & 3) * 8) = vr; \
        float qe0[8], qe1[8], ke0[8], ke1[8]; \
        float a0 = 0.f, a1 = 0.f, p0 = 1.f, p1 = 1.f; \
        _Pragma("unroll") for (int ii = 0; ii < 8; ++ii) { \
            const int i = DIR == 0 ? ii : 7 - ii; \
            const float gg0 = bf_lo(gr[i]), gg1 = bf_hi(gr[i]), q0 = bf_lo(qr[i]), q1 = bf_hi(qr[i]); \
            a0 += gg0; a1 += gg1; \
            const float f0 = __builtin_amdgcn_exp2f(gg0), f1 = __builtin_amdgcn_exp2f(gg1); \
            p0 *= f0; p1 *= f1; \
            qe0[i] = q0 * p0; qe1[i] = q1 * p1; \
            ke0[i] = (1.0f - f0) * __builtin_amdgcn_exp2f(-a0); ke1[i] = (1.0f - f1) * __builtin_amdgcn_exp2f(-a1); } \
        if ((s_) + 2 < 128) S2_LOAD(gr, qr, vr, (s_) + 2); \
        *(LAS f32x2*)(SEG + w * 128 + 2 * lane) = (f32x2){a0, a1}; \
        LDS_BAR(); \
        float off0 = 0.f, off1 = 0.f, ref0 = 0.f, ref1 = 0.f, tot0 = 0.f, tot1 = 0.f; \
        _Pragma("unroll") for (int w2 = 0; w2 < 4; ++w2) { \
            const f32x2 sv = *(const LAS f32x2*)(SEG + w2 * 128 + 2 * lane); \
            tot0 += sv[0]; tot1 += sv[1]; \
            if (DIR == 0 ? (w2 < w) : (w2 > w)) { off0 += sv[0]; off1 += sv[1]; } \
            if (DIR == 0 ? (w2 < 2) : (w2 >= 2)) { ref0 += sv[0]; ref1 += sv[1]; } } \
        const float A0 = __builtin_amdgcn_exp2f(off0 - ref0), A1 = __builtin_amdgcn_exp2f(off1 - ref1); \
        const float B0 = __builtin_amdgcn_exp2f(ref0 - off0), B1 = __builtin_amdgcn_exp2f(ref1 - off1); \
        const float AQ0 = __builtin_amdgcn_exp2f(off0), AQ1 = __builtin_amdgcn_exp2f(off1); \
        const float BK0 = __builtin_amdgcn_exp2f(tot0 - off0), BK1 = __builtin_amdgcn_exp2f(tot1 - off1); \
        _Pragma("unroll") for (int i = 0; i < 8; ++i) { \
            const int t = 8 * w + i; \
            ((LAS unsigned*)(bufp + S2_QT))[t * (S2_LD / 2) + lane] = pk2(qe0[i] * AQ0, qe1[i] * AQ1); \
            ((LAS unsigned*)(bufp + S2_QH))[t * (S2_LD / 2) + lane] = pk2(qe0[i] * A0, qe1[i] * A1); \
            ((LAS unsigned*)(bufp + S2_KH))[t * (S2_LD / 2) + lane] = pk2(ke0[i] * B0, ke1[i] * B1); } \
        { u32x4 wa, wb; wa.x = pk2(ke0[0] * BK0, ke0[1] * BK0); wa.y = pk2(ke0[2] * BK0, ke0[3] * BK0); wa.z = pk2(ke0[4] * BK0, ke0[5] * BK0); wa.w = pk2(ke0[6] * BK0, ke0[7] * BK0); \
          wb.x = pk2(ke1[0] * BK1, ke1[1] * BK1); wb.y = pk2(ke1[2] * BK1, ke1[3] * BK1); wb.z = pk2(ke1[4] * BK1, ke1[5] * BK1); wb.w = pk2(ke1[6] * BK1, ke1[7] * BK1); \
          *(LAS u32x4*)((LAS bf16_t*)(bufp + S2_KT) + (2 * lane) * S2_LDC + 8 * w) = wa; *(LAS u32x4*)((LAS bf16_t*)(bufp + S2_KT) + (2 * lane + 1) * S2_LDC + 8 * w) = wb; } \
        if (w == 0) *(LAS f32x2*)((LAS float*)(lds + S2_ETOT) + ((s_) & 1) * 128 + 2 * lane) = (f32x2){__builtin_amdgcn_exp2f(tot0), __builtin_amdgcn_exp2f(tot1)}; \
        LDS_BAR(); } while (0)
        S2_LOAD(gA, qA, vA, 0); S2_LOAD(gB, qB, vB, 1);
        for (int s = 0; s < 128; s += 2) { S2_PRODUCE(gA, qA, vA, s); S2_PRODUCE(gB, qB, vB, s + 1); }
        LDS_BAR(); LDS_BAR();
#undef S2_LOAD
#undef S2_PRODUCE
    } else {
        const int wb = w - 4;
        f32x16 sacc0, sacc1;
#pragma unroll
        for (int i = 0; i < 16; ++i) { sacc0[i] = 0.f; sacc1[i] = 0.f; }
        LDS_BAR(); LDS_BAR();
        for (int s = 1; s <= 128; ++s) {
            const int cs = s - 1, c = DIR ? 127 - cs : cs;
            const LAS unsigned char* bufp = lds + (cs & 1) * S2_BUF;
            const LAS bf16_t* QT = (const LAS bf16_t*)(bufp + S2_QT); const LAS bf16_t* QH = (const LAS bf16_t*)(bufp + S2_QH); const LAS bf16_t* KH = (const LAS bf16_t*)(bufp + S2_KH);
            const LAS bf16_t* KT = (const LAS bf16_t*)(bufp + S2_KT); const LAS bf16_t* VTT = (const LAS bf16_t*)(bufp + S2_VT);
            const LAS float* ETOT = (const LAS float*)(lds + S2_ETOT) + (cs & 1) * 128;
            f32x16 o, o2;
#pragma unroll
            for (int i = 0; i < 16; ++i) { o[i] = 0.f; o2[i] = 0.f; }
            const int di = (wb - 1) & 1;
            if (wb == 0) {
#pragma unroll
                for (int ks = 0; ks < 8; ks += 2) {
                    o = MFMA32(*(const LAS bf16x8*)(KH + r * S2_LD + 16 * ks + 8 * hh), *(const LAS bf16x8*)(QH + r * S2_LD + 16 * ks + 8 * hh), o);
                    o2 = MFMA32(*(const LAS bf16x8*)(KH + r * S2_LD + 16 * (ks + 1) + 8 * hh), *(const LAS bf16x8*)(QH + r * S2_LD + 16 * (ks + 1) + 8 * hh), o2);
                }
#pragma unroll
                for (int q4 = 0; q4 < 4; ++q4) {
                    const int s0 = 8 * q4 + 4 * hh;
                    float pv[4];
#pragma unroll
                    for (int e = 0; e < 4; ++e) { const int sr = s0 + e; const bool keep = DIR == 0 ? (sr <= r) : (sr >= r); pv[e] = keep ? (o[4 * q4 + e] + o2[4 * q4 + e]) : 0.f; }
                    u32x2 wv; wv.x = pk2(pv[0], pv[1]); wv.y = pk2(pv[2], pv[3]);
                    *(LAS u32x2*)(PL + r * S2_LDC + s0) = wv;
                }
            } else if (wb < 3) {
#pragma unroll
                for (int ks = 0; ks < 8; ks += 2) {
                    o = MFMA32(*(const LAS bf16x8*)(QT + r * S2_LD + 16 * ks + 8 * hh), *(const LAS bf16x8*)(ST + (32 * di + r) * S2_LD + 16 * ks + 8 * hh), o);
                    o2 = MFMA32(*(const LAS bf16x8*)(QT + r * S2_LD + 16 * (ks + 1) + 8 * hh), *(const LAS bf16x8*)(ST + (32 * di + r) * S2_LD + 16 * (ks + 1) + 8 * hh), o2);
                }
            }
            LDS_BAR();
            if (wb == 1 || wb == 2) {
                o = MFMA32(*(const LAS bf16x8*)(PL + r * S2_LDC + 8 * hh), *(const LAS bf16x8*)(VTT + (32 * di + r) * S2_LDC + 8 * hh), o);
                o2 = MFMA32(*(const LAS bf16x8*)(PL + r * S2_LDC + 16 + 8 * hh), *(const LAS bf16x8*)(VTT + (32 * di + r) * S2_LDC + 16 + 8 * hh), o2);
                char* o_u = (char*)OD + (tokbase + 32 * c) * 1024 + (h * 128 + half * 64 + 32 * di) * 2;
                const unsigned o_off = (unsigned)hh * 4096u + 2u * (unsigned)r;
#pragma unroll
                for (int i = 0; i < 16; ++i) { const int tr = (i & 3) + 8 * (i >> 2); *(bf16_t*)(o_u + tr * 1024 + o_off) = (bf16_t)(pk2(o[i] + o2[i], 0.f) & 0xffffu); }
            }
            {
#pragma unroll
                for (int q4 = 0; q4 < 4; ++q4) {
                    const f32x4 et = *(const LAS f32x4*)(ETOT + 32 * wb + 8 * q4 + 4 * hh);
#pragma unroll
                    for (int e = 0; e < 4; ++e) { sacc0[4 * q4 + e] *= et[e]; sacc1[4 * q4 + e] *= et[e]; }
                }
#pragma unroll
                for (int ks = 0; ks < 2; ++ks) {
                    const bf16x8 a = *(const LAS bf16x8*)(KT + (32 * wb + r) * S2_LDC + 16 * ks + 8 * hh);
                    sacc0 = MFMA32(a, *(const LAS bf16x8*)(VTT + r * S2_LDC + 16 * ks + 8 * hh), sacc0);
                    sacc1 = MFMA32(a, *(const LAS bf16x8*)(VTT + (32 + r) * S2_LDC + 16 * ks + 8 * hh), sacc1);
                }
#pragma unroll
                for (int q4 = 0; q4 < 4; ++q4) {
                    u32x2 w0, w1; w0.x = pk2(sacc0[4 * q4], sacc0[4 * q4 + 1]); w0.y = pk2(sacc0[4 * q4 + 2], sacc0[4 * q4 + 3]);
                    w1.x = pk2(sacc1[4 * q4], sacc1[4 * q4 + 1]); w1.y = pk2(sacc1[4 * q4 + 2], sacc1[4 * q4 + 3]);
                    *(LAS u32x2*)(ST + r * S2_LD + 32 * wb + 8 * q4 + 4 * hh) = w0;
                    *(LAS u32x2*)(ST + (32 + r) * S2_LD + 32 * wb + 8 * q4 + 4 * hh) = w1;
                }
            }
            LDS_BAR();
        }
    }
    LDS_BAR();
}

constexpr int AT_K = 0, AT_V = 61440, AT_RP = 122880 + 256;
__device__ __forceinline__ void phase_attn(const Params& P, LAS unsigned char* lds) {
    const int tid = threadIdx.x, wave = __builtin_amdgcn_readfirstlane(tid >> 6), lane = tid & 63;
    const int qi = lane & 15, g = lane >> 4;
    const bf16_t* Q = (const bf16_t*)(P.ws + OFF_Q); const bf16_t* Kp = (const bf16_t*)(P.ws + OFF_K);
    const bf16_t* VT = (const bf16_t*)(P.ws + OFF_VT); const bf16_t* SG = (const bf16_t*)(P.ws + OFF_SG);
    bf16_t* mix = (bf16_t*)(P.ws + OFF_MIX);
    LAS float* rpl = (LAS float*)(lds + AT_RP);
    const int jrow = 8 * (qi >> 2) + (qi & 3);
    u32x4 pk_[8], pv_[8];
#define AT_ISSUE(rnd_) do { const int h_ = (rnd_) & 7, n_ = ((rnd_) >> 3) & 3, rh_ = ((rnd_) >> 5) & 7, b_ = (rnd_) >> 8; \
        const int R0_ = min(max(8 * rh_ - 4, 0), 49), bs_ = min(max(16 * n_ - 8, 0), 32); \
        const bf16_t* kt_ = Kp + ((size_t)(b_ * 8 + h_) * 4096 + R0_ * 64 + bs_) * 64; \
        const bf16_t* vt_ = VT + ((size_t)(b_ * 8 + h_) * 64 + R0_) * 4096 + bs_; \
        _Pragma("unroll") for (int i = 0; i < 8; ++i) { const int q = tid + 512 * i; if (q < 3840) { \
            pk_[i] = *(const u32x4*)(kt_ + (q >> 8) * 4096 + ((q >> 3) & 31) * 64 + (q & 7) * 8); \
            pv_[i] = *(const u32x4*)(vt_ + (q >> 8) * 4096 + ((q >> 2) & 63) * 64 + (q & 3) * 8); } } } while (0)
    bf16x8 qn[2]; u32x2 gn[4];
#define AT_ISSUE_Q(rnd_) do { const int h_ = (rnd_) & 7, n_ = ((rnd_) >> 3) & 3, rr_ = (((rnd_) >> 5) & 7) * 8 + wave, b_ = (rnd_) >> 8; \
        const bf16_t* qq_ = Q + ((size_t)(b_ * 8 + h_) * 4096 + rr_ * 64 + 16 * n_) * 64 + qi * 64 + 8 * g; \
        const bf16_t* sg_ = SG + ((size_t)b_ * 4096 + rr_ * 64 + 16 * n_) * 512 + h_ * 64 + qi * 512 + 4 * g; \
        qn[0] = *(const bf16x8*)qq_; qn[1] = *(const bf16x8*)(qq_ + 32); \
        gn[0] = *(const u32x2*)sg_; gn[1] = *(const u32x2*)(sg_ + 16); gn[2] = *(const u32x2*)(sg_ + 32); gn[3] = *(const u32x2*)(sg_ + 48); } while (0)
    int rnd = blockIdx.x;
    if (rnd < 4096) { AT_ISSUE(rnd); AT_ISSUE_Q(rnd); }
    for (; rnd < 4096; rnd += gridDim.x) {
        const int h = rnd & 7, n = (rnd >> 3) & 3, rh = (rnd >> 5) & 7, b = rnd >> 8;
        const int R0 = min(max(8 * rh - 4, 0), 49), bs = min(max(16 * n - 8, 0), 32);
        __syncthreads();
#pragma unroll
        for (int i = 0; i < 8; ++i) { const int q = tid + 512 * i; if (q < 3840) {
            const int col = (q >> 3) & 31, d = (q >> 2) & 63;
            *(LAS u32x4*)(lds + AT_K + ((q >> 8) * 32 + col) * 128 + (((q & 7) ^ (((col >> 1) & 1) | (((col >> 3) & 3) << 1))) * 16)) = pk_[i];
            *(LAS u32x4*)(lds + AT_V + ((q >> 8) * 64 + d) * 64 + (((q & 3) ^ ((d >> 2) & 3)) * 16)) = pv_[i]; } }
        if (tid < 465) rpl[tid] = P.rpb[h * 465 + tid] * 1.4426950408889634f;
        __syncthreads();
        const bf16x8 qf[2] = {qn[0], qn[1]};
        const u32x2 gw2[4] = {gn[0], gn[1], gn[2], gn[3]};
        { const int nx = rnd + gridDim.x; if (nx < 4096) { AT_ISSUE(nx); AT_ISSUE_Q(nx); } }
        const int rr = 8 * rh + wave;
        const int rs = min(max(rr - 4, 0), 56), lrow0 = rs - R0;
        const int qc = 16 * n + qi, cs = min(max(qc - 8, 0), 48);
        bf16_t* mix_u = mix + ((size_t)b * 4096 + rr * 64 + 16 * n) * 1024 + h * 64;
        f32x4 sacc[16];
#pragma unroll
        for (int kb = 0; kb < 16; ++kb) {
            const int jc = jrow + 4 * (kb & 1);
            const LAS unsigned char* kr = lds + AT_K + ((lrow0 + (kb >> 1)) * 32 + jc) * 128;
            const int sw = ((jc >> 1) & 1) | (((jc >> 3) & 3) << 1);
            const bf16x8 k0 = *(const LAS bf16x8*)(kr + ((g ^ sw) * 16));
            const bf16x8 k1 = *(const LAS bf16x8*)(kr + (((4 + g) ^ sw) * 16));
            sacc[kb] = MFMA16(k0, qf[0], ((f32x4){0.f, 0.f, 0.f, 0.f}));
            sacc[kb] = MFMA16(k1, qf[1], sacc[kb]);
        }
        const LAS float* rp = rpl + (rs - rr + 7) * 31 + (bs + 8 * g - qc + 15);
        const int kc0 = bs + 8 * g;
        float mx = -INFINITY;
#pragma unroll
        for (int kb = 0; kb < 16; ++kb) {
#pragma unroll
            for (int j = 0; j < 4; ++j) {
                const int kc = kc0 + 4 * (kb & 1) + j;
                const bool valid = (kc >= cs) && (kc < cs + 16);
                float s = sacc[kb][j] + rp[(kb >> 1) * 31 + 4 * (kb & 1) + j];
                s = valid ? s : -INFINITY;
                sacc[kb][j] = s; mx = fmaxf(mx, s);
            }
        }
        mx = fmaxf(mx, __shfl_xor(mx, 16)); mx = fmaxf(mx, __shfl_xor(mx, 32));
        float sum = 0.f;
#pragma unroll
        for (int kb = 0; kb < 16; ++kb)
#pragma unroll
            for (int j = 0; j < 4; ++j) { const float pe = __builtin_amdgcn_exp2f(sacc[kb][j] - mx); sacc[kb][j] = pe; sum += pe; }
        sum += __shfl_xor(sum, 16); sum += __shfl_xor(sum, 32);
        f32x4 oacc[4];
#pragma unroll
        for (int db = 0; db < 4; ++db) oacc[db] = (f32x4){0.f, 0.f, 0.f, 0.f};
#pragma unroll
        for (int c = 0; c < 8; ++c) {
            u32x4 pw; pw.x = pk2(sacc[2 * c][0], sacc[2 * c][1]); pw.y = pk2(sacc[2 * c][2], sacc[2 * c][3]);
            pw.z = pk2(sacc[2 * c + 1][0], sacc[2 * c + 1][1]); pw.w = pk2(sacc[2 * c + 1][2], sacc[2 * c + 1][3]);
            const bf16x8 pf = __builtin_bit_cast(bf16x8, pw);
#pragma unroll
            for (int db = 0; db < 4; ++db) {
                const int d = db * 16 + qi;
                const bf16x8 vfr = *(const LAS bf16x8*)(lds + AT_V + ((lrow0 + c) * 64 + d) * 64 + ((g ^ ((d >> 2) & 3)) * 16));
                oacc[db] = MFMA16(vfr, pf, oacc[db]);
            }
        }
        const float inv = __builtin_amdgcn_rcpf(sum);
        float ssq = 0.f;
#pragma unroll
        for (int db = 0; db < 4; ++db)
#pragma unroll
            for (int j = 0; j < 4; ++j) { const float ov = oacc[db][j] * inv; oacc[db][j] = ov; ssq += ov * ov; }
        ssq += __shfl_xor(ssq, 16); ssq += __shfl_xor(ssq, 32);
        const float rn = rsqrtf(ssq * (1.0f / 64.0f) + EPS);
#pragma unroll
        for (int db = 0; db < 4; ++db) {
            const int col = h * 64 + db * 16 + 4 * g;
            const f32x4 an = *(const f32x4*)(P.attn_norm + col);
            u32x2 wv;
            wv.x = pk2(oacc[db][0] * rn * an[0] * siluf_(bf_lo(gw2[db].x)), oacc[db][1] * rn * an[1] * siluf_(bf_hi(gw2[db].x)));
            wv.y = pk2(oacc[db][2] * rn * an[2] * siluf_(bf_lo(gw2[db].y)), oacc[db][3] * rn * an[3] * siluf_(bf_hi(gw2[db].y)));
            *(u32x2*)(mix_u + db * 16 + qi * 1024 + 4 * g) = wv;
        }
    }
    __syncthreads();
#undef AT_ISSUE
#undef AT_ISSUE_Q
}

__device__ __forceinline__ void phase_hpost(const Params& P) {
    const int tid = threadIdx.x, wave = tid >> 6, lane = tid & 63;
    const int gw = blockIdx.x * 8 + wave, NGW = gridDim.x * 8;
    const bf16_t* O0 = (const bf16_t*)(P.ws + OFF_OD); const bf16_t* O1 = (const bf16_t*)(P.ws + OFF_OD + 64 * MiB);
    const bf16_t* SHG = (const bf16_t*)(P.ws + OFF_SHG);
    bf16_t* mix = (bf16_t*)(P.ws + OFF_MIX);
    const int c0 = 8 * lane;
    const f32x4 n0 = *(const f32x4*)(P.hgrn_norm + c0), n1 = *(const f32x4*)(P.hgrn_norm + c0 + 4);
    const float nw[8] = {n0[0], n0[1], n0[2], n0[3], n1[0], n1[1], n1[2], n1[3]};
    for (int tok = gw; tok < NTOK; tok += NGW) {
        const u32x4 a = *(const u32x4*)(O0 + (size_t)tok * 512 + c0), bq = *(const u32x4*)(O1 + (size_t)tok * 512 + c0), gt = *(const u32x4*)(SHG + (size_t)tok * 512 + c0);
        float v[8] = {bf_lo(a.x) + bf_lo(bq.x), bf_hi(a.x) + bf_hi(bq.x), bf_lo(a.y) + bf_lo(bq.y), bf_hi(a.y) + bf_hi(bq.y),
                      bf_lo(a.z) + bf_lo(bq.z), bf_hi(a.z) + bf_hi(bq.z), bf_lo(a.w) + bf_lo(bq.w), bf_hi(a.w) + bf_hi(bq.w)};
        const float gv[8] = {bf_lo(gt.x), bf_hi(gt.x), bf_lo(gt.y), bf_hi(gt.y), bf_lo(gt.z), bf_hi(gt.z), bf_lo(gt.w), bf_hi(gt.w)};
        float s = 0.f;
#pragma unroll
        for (int e = 0; e < 8; ++e) s += v[e] * v[e];
        s += __shfl_xor(s, 1); s += __shfl_xor(s, 2); s += __shfl_xor(s, 4); s += __shfl_xor(s, 8);
        const float rn = rsqrtf(s * (1.0f / 128.0f) + EPS);
#pragma unroll
        for (int e = 0; e < 8; ++e) v[e] = v[e] * rn * nw[e] * gv[e];
        u32x4 wv; wv.x = pk2(v[0], v[1]); wv.y = pk2(v[2], v[3]); wv.z = pk2(v[4], v[5]); wv.w = pk2(v[6], v[7]);
        *(u32x4*)(mix + (size_t)tok * 1024 + 512 + c0) = wv;
    }
}

__device__ __forceinline__ void phase_final(const Params& P) {
    const int tid = threadIdx.x, wave = tid >> 6, lane = tid & 63;
    const int gw = blockIdx.x * 8 + wave, NGW = gridDim.x * 8;
    const float* ss3 = (const float*)(P.ws + OFF_SS3);
    f32x4 lw[4];
#pragma unroll
    for (int j = 0; j < 4; ++j) lw[j] = ((const f32x4*)P.ln_final)[lane + 64 * j];
    for (int row = gw; row < NTOK; row += NGW) {
        const float rs = rsqrtf(ss3[row] * (1.0f / 1024.0f) + EPS);
        f32x4* o = (f32x4*)(P.out + (size_t)row * 1024) + lane;
#pragma unroll
        for (int j = 0; j < 4; ++j) { f32x4 v = o[64 * j]; v = v * rs * lw[j]; o[64 * j] = v; }
    }
}

#define BLOCK_HANDOFF() do { __builtin_amdgcn_fence(__ATOMIC_RELEASE, "workgroup"); __syncthreads(); __builtin_amdgcn_fence(__ATOMIC_ACQUIRE, "workgroup"); } while (0)
__device__ __forceinline__ void phase_tail(const Params& P, LAS unsigned char* lds) {
    int tid_ = threadIdx.x; asm volatile("" : "+v"(tid_));
    const int tid = tid_, wave = __builtin_amdgcn_readfirstlane(tid >> 6), lane = tid & 63;
    LAS float* ss2l = (LAS float*)(lds + 131072); LAS float* ss3l = ss2l + 256;
    const bf16_t* O0 = (const bf16_t*)(P.ws + OFF_OD); const bf16_t* O1 = (const bf16_t*)(P.ws + OFF_OD + 64 * MiB);
    const bf16_t* SHG = (const bf16_t*)(P.ws + OFF_SHG);
    bf16_t* mix = (bf16_t*)(P.ws + OFF_MIX);
    {
        const int panel = blockIdx.x;
        __syncthreads();
        ss2l[tid] = 0.f;
        const bool odd = (blockIdx.x & 1) != 0;
        if (odd) { __syncthreads();
        {
            pg8::PanelOrder S{panel, 4};
            pg8::Gemm g{(const bf16_t*)(P.ws + OFF_PB), (const bf16_t*)(P.ws + OFF_W4T), NTOK, 1024, 256};
            EpiPP E{(bf16_t*)(P.ws + OFF_PP)};
            pg8::gemm_phase(lds, g, S, E);
        }
        }
        {
            const int c0 = 8 * lane;
            const f32x4 n0 = *(const f32x4*)(P.hgrn_norm + c0), n1 = *(const f32x4*)(P.hgrn_norm + c0 + 4);
            const float nw[8] = {n0[0], n0[1], n0[2], n0[3], n1[0], n1[1], n1[2], n1[3]};
#pragma unroll 8
            for (int i = 0; i < 32; ++i) {
                const size_t tok = (size_t)panel * 256 + wave * 32 + i;
                const u32x4 a = *(const u32x4*)(O0 + tok * 512 + c0), bq = *(const u32x4*)(O1 + tok * 512 + c0), gt = *(const u32x4*)(SHG + tok * 512 + c0);
                float v[8] = {bf_lo(a.x) + bf_lo(bq.x), bf_hi(a.x) + bf_hi(bq.x), bf_lo(a.y) + bf_lo(bq.y), bf_hi(a.y) + bf_hi(bq.y),
                              bf_lo(a.z) + bf_lo(bq.z), bf_hi(a.z) + bf_hi(bq.z), bf_lo(a.w) + bf_lo(bq.w), bf_hi(a.w) + bf_hi(bq.w)};
                const float gv[8] = {bf_lo(gt.x), bf_hi(gt.x), bf_lo(gt.y), bf_hi(gt.y), bf_lo(gt.z), bf_hi(gt.z), bf_lo(gt.w), bf_hi(gt.w)};
                float s = 0.f;
#pragma unroll
                for (int e = 0; e < 8; ++e) s += v[e] * v[e];
                s += __shfl_xor(s, 1); s += __shfl_xor(s, 2); s += __shfl_xor(s, 4); s += __shfl_xor(s, 8);
                const float rn = rsqrtf(s * (1.0f / 128.0f) + EPS);
#pragma unroll
                for (int e = 0; e < 8; ++e) v[e] = v[e] * rn * nw[e] * siluf_(gv[e]);
                u32x4 wv; wv.x = pk2(v[0], v[1]); wv.y = pk2(v[2], v[3]); wv.z = pk2(v[4], v[5]); wv.w = pk2(v[6], v[7]);
                *(u32x4*)(mix + tok * 1024 + 512 + c0) = wv;
            }
        }
        BLOCK_HANDOFF();
        {
            pg8::PanelOrder S{panel, 4};
            pg8::Gemm g{(const bf16_t*)(P.ws + OFF_MIX), (const bf16_t*)(P.ws + OFF_W2T), NTOK, 1024, 1024};
            Epi2P E{P.x, P.out, (bf16_t*)(P.ws + OFF_HB), ss2l};
            pg8::gemm_phase(lds, g, S, E);
        }
        if (!odd) {
        {
            pg8::PanelOrder S{panel, 4};
            pg8::Gemm g{(const bf16_t*)(P.ws + OFF_PB), (const bf16_t*)(P.ws + OFF_W4T), NTOK, 1024, 256};
            EpiPP E{(bf16_t*)(P.ws + OFF_PP)};
            pg8::gemm_phase(lds, g, S, E);
        }
        }
        BLOCK_HANDOFF();
        {
            pg8::PanelOrder S{panel, 4};
            pg8::Gemm g{(const bf16_t*)(P.ws + OFF_HB), (const bf16_t*)(P.ws + OFF_W3T), NTOK, 1024, 1024};
            Epi3P E{(bf16_t*)(P.ws + OFF_HFB), (const bf16_t*)(P.ws + OFF_PP), (const bf16_t*)(P.ws + OFF_HB), ss2l, ss3l};
            pg8::gemm_phase(lds, g, S, E);
        }
        BLOCK_HANDOFF();
        {
            const bf16_t* hfb = (const bf16_t*)(P.ws + OFF_HFB);
            f32x4 lw[4];
#pragma unroll
            for (int j = 0; j < 2; ++j) { lw[2 * j] = *(const f32x4*)(P.ln_final + lane * 8 + 512 * j); lw[2 * j + 1] = *(const f32x4*)(P.ln_final + lane * 8 + 512 * j + 4); }
#pragma unroll 8
            for (int i = 0; i < 32; ++i) {
                const int lrow = wave * 32 + i;
                const float rs = rsqrtf(ss3l[lrow] * (1.0f / 1024.0f) + EPS);
                const size_t ro = ((size_t)panel * 256 + lrow) * 1024 + lane * 8;
                const u32x4 a = *(const u32x4*)(hfb + ro), bq = *(const u32x4*)(hfb + ro + 512);
                f32x4 v0 = {bf_lo(a.x), bf_hi(a.x), bf_lo(a.y), bf_hi(a.y)}, v1 = {bf_lo(a.z), bf_hi(a.z), bf_lo(a.w), bf_hi(a.w)};
                f32x4 v2 = {bf_lo(bq.x), bf_hi(bq.x), bf_lo(bq.y), bf_hi(bq.y)}, v3 = {bf_lo(bq.z), bf_hi(bq.z), bf_lo(bq.w), bf_hi(bq.w)};
                *(f32x4*)(P.out + ro) = v0 * rs * lw[0]; *(f32x4*)(P.out + ro + 4) = v1 * rs * lw[1];
                *(f32x4*)(P.out + ro + 512) = v2 * rs * lw[2]; *(f32x4*)(P.out + ro + 516) = v3 * rs * lw[3];
            }
        }
    }
}

template <int PH> __device__ __forceinline__ void run_phase(const Params& P, LAS unsigned char* lds) {
    if constexpr (PH == 0) {
        phase_prep(P);
    } else if constexpr (PH == 1) {
        pg8::StaticOrder S; S.init(NTOK, 4608, (int)gridDim.x, (int)blockIdx.x);
        pg8::Gemm g{(const bf16_t*)(P.ws + OFF_XB), (const bf16_t*)(P.ws + OFF_W1T), NTOK, 4608, 1024};
        Epi1 E{P.ws, 0};
        pg8::gemm_phase(lds, g, S, E);
    } else if constexpr (PH == 2) {
#ifndef SKIP_SCAN
        for (int task = blockIdx.x; task < 256; task += gridDim.x) { if (task >> 7) hgrn_scan2<1>(P, lds, task); else hgrn_scan2<0>(P, lds, task); }
#if PROBE_DUP == 20
        for (int task = blockIdx.x; task < 256; task += gridDim.x) { if (task >> 7) hgrn_scan2<1>(P, lds, task); else hgrn_scan2<0>(P, lds, task); }
#endif
#else
        { u32x4* od = (u32x4*)(P.ws + OFF_OD); for (size_t i = (size_t)blockIdx.x * 512 + threadIdx.x; i < (128 * MiB) / 16; i += (size_t)gridDim.x * 512) od[i] = (u32x4){0u, 0u, 0u, 0u}; }
#endif
        phase_attn(P, lds);
#if PROBE_DUP == 21
        phase_attn(P, lds);
#endif
    } else if constexpr (PH == 3) {
        phase_hpost(P);
        __syncthreads();
        pg8::StaticOrder S; S.init(NTOK, 1024, (int)gridDim.x, (int)blockIdx.x);
        pg8::Gemm g{(const bf16_t*)(P.ws + OFF_PB), (const bf16_t*)(P.ws + OFF_W4T), NTOK, 1024, 256};
        EpiPP E{(bf16_t*)(P.ws + OFF_PP)};
        pg8::gemm_phase(lds, g, S, E);
    } else if constexpr (PH == 4) {
        pg8::StaticOrder S; S.init(NTOK, 1024, (int)gridDim.x, (int)blockIdx.x);
        pg8::Gemm g{(const bf16_t*)(P.ws + OFF_MIX), (const bf16_t*)(P.ws + OFF_W2T), NTOK, 1024, 1024};
        Epi2 E{P.x, P.out, (bf16_t*)(P.ws + OFF_HB), (float*)(P.ws + OFF_SS2)};
        pg8::gemm_phase(lds, g, S, E);
    } else if constexpr (PH == 5) {
        pg8::StaticOrder S; S.init(NTOK, 1024, (int)gridDim.x, (int)blockIdx.x);
        pg8::Gemm g{(const bf16_t*)(P.ws + OFF_HB), (const bf16_t*)(P.ws + OFF_W3T), NTOK, 1024, 1024};
        Epi3 E{P.out, (const bf16_t*)(P.ws + OFF_PP), (const float*)(P.ws + OFF_SS2), (float*)(P.ws + OFF_SS3)};
        pg8::gemm_phase(lds, g, S, E);
    } else {
        phase_final(P);
    }
}
#if N_LAUNCHES == 1
__global__ __launch_bounds__(512, 2) void fwd_kernel(Params P) {
    extern __shared__ __attribute__((aligned(16))) unsigned char shm[];
    LAS unsigned char* lds = (LAS unsigned char*)shm;
    cg::grid_group grid = cg::this_grid();
    volatile LAS unsigned* xst = (volatile LAS unsigned*)(lds + 131072 + 2048);
    if (threadIdx.x == 0) { xst[0] = 0u; xst[1] = 0u; }
    __syncthreads();
    const XcdBarrier xb = xcd_barrier_post((unsigned*)(P.ws + OFF_BAR), xst);
    run_phase<0>(P, lds); xcd_barrier(xb);
    {
        const int wave_ = __builtin_amdgcn_readfirstlane((int)threadIdx.x >> 6), lane_ = (int)threadIdx.x & 63;
        const bool odd_ = (blockIdx.x & 1) != 0;
        if (odd_) convert_x_rows(P, NTOK / 2 + (int)blockIdx.x * 128, 128, wave_, 8, lane_);
        {
            pg8::StaticOrder S; S.init(NTOK / 2, 4608, (int)gridDim.x, (int)blockIdx.x);
            pg8::Gemm g{(const bf16_t*)(P.ws + OFF_XB), (const bf16_t*)(P.ws + OFF_W1T), NTOK / 2, 4608, 1024};
            Epi1 E{P.ws, 0};
            pg8::gemm_phase(lds, g, S, E);
        }
        if (!odd_) convert_x_rows(P, NTOK / 2 + (int)blockIdx.x * 128, 128, wave_, 8, lane_);
    }
    xcd_barrier(xb);
    {
        pg8::StaticOrder S; S.init(NTOK / 2, 4608, (int)gridDim.x, (int)blockIdx.x);
        pg8::Gemm g{(const bf16_t*)(P.ws + OFF_XB) + (size_t)(NTOK / 2) * 1024, (const bf16_t*)(P.ws + OFF_W1T), NTOK / 2, 4608, 1024};
        Epi1 E{P.ws, NTOK / 2};
        pg8::gemm_phase(lds, g, S, E);
    }
    xcd_barrier(xb);
    run_phase<2>(P, lds); xcd_barrier(xb);
    phase_tail(P, lds);
    if (P.ws == nullptr) grid.sync();
}
#else
template <int PH> __global__ __launch_bounds__(512, 2) void k_ph(Params P) {
    extern __shared__ __attribute__((aligned(16))) unsigned char shm[];
    run_phase<PH>(P, (LAS unsigned char*)shm);
}
#endif

extern "C" void kernel_launch(void* const* d_in, const int* in_sizes, int n_in, void* d_out, int out_size, void* d_ws, size_t ws_size, hipStream_t stream) {
    static int grid = 0;
    if (grid == 0) {
        if (n_in != 13 || out_size != NTOK * DM || ws_size < WS_END) { fprintf(stderr, "kernel_launch: unexpected shapes (n_in %d out %d ws %zu)\n", n_in, out_size, ws_size); grid = -1; return; }
        int dev = 0, cus = 0;
        (void)hipGetDevice(&dev);
        (void)hipDeviceGetAttribute(&cus, hipDeviceAttributeMultiprocessorCount, dev);
        bool ok = true;
#if N_LAUNCHES == 1
        ok = ok && hipFuncSetAttribute((const void*)fwd_kernel, hipFuncAttributeMaxDynamicSharedMemorySize, LDS_BYTES) == hipSuccess;
        int per_cu = 0;
        (void)hipOccupancyMaxActiveBlocksPerMultiprocessor(&per_cu, (const void*)fwd_kernel, 512, LDS_BYTES);
        if (per_cu < 1) fprintf(stderr, "kernel_launch: occupancy query says %d blocks per CU\n", per_cu);
#else
        ok = ok && hipFuncSetAttribute((const void*)k_ph<0>, hipFuncAttributeMaxDynamicSharedMemorySize, LDS_BYTES) == hipSuccess;
        ok = ok && hipFuncSetAttribute((const void*)k_ph<1>, hipFuncAttributeMaxDynamicSharedMemorySize, LDS_BYTES) == hipSuccess;
        ok = ok && hipFuncSetAttribute((const void*)k_ph<2>, hipFuncAttributeMaxDynamicSharedMemorySize, LDS_BYTES) == hipSuccess;
        ok = ok && hipFuncSetAttribute((const void*)k_ph<3>, hipFuncAttributeMaxDynamicSharedMemorySize, LDS_BYTES) == hipSuccess;
        ok = ok && hipFuncSetAttribute((const void*)k_ph<4>, hipFuncAttributeMaxDynamicSharedMemorySize, LDS_BYTES) == hipSuccess;
        ok = ok && hipFuncSetAttribute((const void*)k_ph<5>, hipFuncAttributeMaxDynamicSharedMemorySize, LDS_BYTES) == hipSuccess;
        ok = ok && hipFuncSetAttribute((const void*)k_ph<6>, hipFuncAttributeMaxDynamicSharedMemorySize, LDS_BYTES) == hipSuccess;
#endif
        (void)hipGetLastError();
        if (!ok) { fprintf(stderr, "kernel_launch: hipFuncSetAttribute failed\n"); grid = -1; return; }
        grid = 256;
        if (cus < 256) { fprintf(stderr, "kernel_launch: needs 256 CUs (one 256-row panel per workgroup), device has %d\n", cus); grid = -1; return; }
    }
    if (grid < 0) return;
    Params P{};
    P.x = (const float*)d_in[0]; P.p = (const float*)d_in[1]; P.ln_mix = (const float*)d_in[2]; P.w_in = (const float*)d_in[3]; P.rpb = (const float*)d_in[4];
    P.lb_logits = (const float*)d_in[5]; P.attn_norm = (const float*)d_in[6]; P.hgrn_norm = (const float*)d_in[7]; P.w_out = (const float*)d_in[8];
    P.ln_ple = (const float*)d_in[9]; P.w_pg = (const float*)d_in[10]; P.w_pp = (const float*)d_in[11]; P.ln_final = (const float*)d_in[12];
    P.out = (float*)d_out; P.ws = (unsigned char*)d_ws;
#if N_LAUNCHES == 1
    if (hipMemsetAsync((char*)d_ws + OFF_BAR, 0, XCD_BAR_WORDS * sizeof(unsigned), stream) != hipSuccess) { fprintf(stderr, "kernel_launch: hipMemsetAsync of the barrier words failed\n"); return; }
    void* args[] = {&P};
    hipError_t e = hipLaunchCooperativeKernel((const void*)fwd_kernel, dim3(grid), dim3(512), args, LDS_BYTES, stream);
    if (e != hipSuccess) fprintf(stderr, "cooperative launch failed: %s (grid %d)\n", hipGetErrorString(e), grid);
#else
    hipLaunchKernelGGL(k_ph<0>, dim3(grid), dim3(512), LDS_BYTES, stream, P);
    hipLaunchKernelGGL(k_ph<1>, dim3(grid), dim3(512), LDS_BYTES, stream, P);
    hipLaunchKernelGGL(k_ph<2>, dim3(grid), dim3(512), LDS_BYTES, stream, P);
    hipLaunchKernelGGL(k_ph<3>, dim3(grid), dim3(512), LDS_BYTES, stream, P);
    hipLaunchKernelGGL(k_ph<4>, dim3(grid), dim3(512), LDS_BYTES, stream, P);
    hipLaunchKernelGGL(k_ph<5>, dim3(grid), dim3(512), LDS_BYTES, stream, P);
    hipLaunchKernelGGL(k_ph<6>, dim3(grid), dim3(512), LDS_BYTES, stream, P);
#endif
}
```
